# Optimizing an MI355X kernel written in HIP

```python
import jax, jax.numpy as jnp
from jax import lax
import numpy as np

D_MODEL = 1024
BATCH = 32
SEQ = 256
DEPTH = 4
DEC_BATCH = 4
DEC_SEQ = 4096
PAST_LEN = 256

F32 = jnp.float32
GRID_W = 64
Q_BLOCK = 128
LN_EPS = 1e-6
RMS_EPS = 1e-6
ROPE_THETA = 10000.0
DEEPNORM_ALPHA = (2 * DEPTH) ** 0.25
DEEPNORM_BETA = (8 * DEPTH) ** -0.25
N_MOD = 9
D_FF = 2816

LRU_WIDTH = 256
LRU_BLOCKS = 4
LRU_BLOCK_W = LRU_WIDTH // LRU_BLOCKS
CONV_W = 4
CONV_PAD_LO = 1
LRU_C = 8.0
GQA_HEADS = 8
GQA_KV_HEADS = 2
HEAD_DIM = 64
MLA_HEADS = 4
MLA_Q_RANK = 192
MLA_KV_RANK = 128
MLA_NOPE_DIM = 64
MLA_ROPE_DIM = 32
MLA_V_DIM = 64

IN_WIDTHS = (LRU_WIDTH, LRU_WIDTH, GQA_HEADS * HEAD_DIM, GQA_KV_HEADS * HEAD_DIM, GQA_KV_HEADS * HEAD_DIM, MLA_Q_RANK, MLA_KV_RANK, MLA_ROPE_DIM)
IN_COLS = 2 * LRU_WIDTH + (GQA_HEADS + 2 * GQA_KV_HEADS) * HEAD_DIM + MLA_Q_RANK + MLA_KV_RANK + MLA_ROPE_DIM
MIX_WIDTH = LRU_WIDTH + GQA_HEADS * HEAD_DIM + MLA_HEADS * MLA_V_DIM

kernel_name = 'hybrid_diffusion_lru_gqa_mla_step'


def layer_norm(x, g, b):
    xf = x.astype(F32)
    mu = jnp.mean(xf, axis=-1, keepdims=True)
    var = jnp.mean(jnp.square(xf - mu), axis=-1, keepdims=True)
    return ((xf - mu) * lax.rsqrt(var + LN_EPS) * g.astype(F32) + b.astype(F32)).astype(x.dtype)


def rms_norm(x, g):
    xf = x.astype(F32)
    return (xf * lax.rsqrt(jnp.mean(xf * xf, axis=-1, keepdims=True) + RMS_EPS) * g.astype(F32)).astype(x.dtype)


def grid_rope(num_tokens, dim):
    rows = num_tokens // GRID_W
    row = jnp.repeat(jnp.arange(rows), GRID_W).astype(F32)
    col = jnp.tile(jnp.arange(GRID_W), rows).astype(F32)
    n_freq = dim // 4
    inv = ROPE_THETA ** (-jnp.arange(n_freq, dtype=F32) / n_freq)
    ang = jnp.concatenate([row[:, None] * inv, col[:, None] * inv], axis=-1)
    return jnp.cos(ang), jnp.sin(ang)


def apply_rope(x, cos, sin):
    xf = x.astype(F32)
    half = x.shape[-1] // 2
    x1, x2 = xf[..., :half], xf[..., half:]
    c = cos[None, :, None, :]
    s = sin[None, :, None, :]
    return jnp.concatenate([x1 * c - x2 * s, x1 * s + x2 * c], axis=-1).astype(x.dtype)


def attention(q, k, v):
    b, tq, h, dq = q.shape
    kvh = k.shape[2]
    grp = h // kvh
    dv = v.shape[-1]
    scale = dq ** -0.5
    nblk = tq // Q_BLOCK
    qb = q.reshape(b, nblk, Q_BLOCK, kvh, grp, dq).transpose(1, 0, 2, 3, 4, 5)

    def block(qi):
        s = jnp.einsum('bqkgd,bskd->bkgqs', qi, k, preferred_element_type=F32) * scale
        p = jax.nn.softmax(s, axis=-1).astype(v.dtype)
        return jnp.einsum('bkgqs,bskd->bqkgd', p, v)

    o = lax.map(block, qb)
    return o.transpose(1, 0, 2, 3, 4, 5).reshape(b, tq, h * dv)


def depthwise_conv(x, w, bias):
    y = lax.conv_general_dilated(x, w[:, None, :], window_strides=(1,), padding=[(CONV_PAD_LO, CONV_W - 1 - CONV_PAD_LO)], dimension_numbers=('NWC', 'WIO', 'NWC'), feature_group_count=x.shape[-1])
    return y + bias


def rglru_scan(x, h0, lam, w_a, b_a, w_i, b_i, reverse):
    b, t, w = x.shape
    xf = x.astype(F32)
    xb = xf.reshape(b, t, LRU_BLOCKS, LRU_BLOCK_W)
    r = jax.nn.sigmoid(jnp.einsum('btnk,nkj->btnj', xb, w_a.astype(F32)).reshape(b, t, w) + b_a.astype(F32))
    i = jax.nn.sigmoid(jnp.einsum('btnk,nkj->btnj', xb, w_i.astype(F32)).reshape(b, t, w) + b_i.astype(F32))
    log_a = -LRU_C * r * jax.nn.softplus(-lam.astype(F32))
    a = jnp.exp(log_a)
    u = jnp.sqrt(-jnp.expm1(2.0 * log_a)) * (i * xf)

    def step(h, au):
        a_t, u_t = au
        h = a_t * h + u_t
        return h, h

    h_last, hs = lax.scan(step, h0.astype(F32), (jnp.swapaxes(a, 0, 1), jnp.swapaxes(u, 0, 1)), reverse=reverse)
    return jnp.swapaxes(hs, 0, 1), h_last


def split_in(z):
    out, off = [], 0
    for wdt in IN_WIDTHS:
        out.append(z[..., off:off + wdt])
        off += wdt
    return out


def swiglu(u, lp, j):
    return (jax.nn.silu(u @ lp['ffn_w_gate'][j]) * (u @ lp['ffn_w_up'][j])) @ lp['ffn_w_down'][j]


def mixer(u, lp, ropes, ctx):
    b, t, _ = u.shape
    xa, ga, qg, kg, vg, cq, ckv, kr = split_in(u @ lp['w_in'])

    xc = depthwise_conv(xa, lp['conv_w'], lp['conv_b'])
    if ctx is None:
        hf0 = jnp.zeros((b, LRU_WIDTH), F32)
        hb0 = jnp.zeros((b, LRU_WIDTH), F32)
    else:
        hf0 = ctx['lru'][:, 0]
        hb0 = ctx['lru'][:, 1]
    hf, hf_last = rglru_scan(xc, hf0, lp['lru_lambda'][0], lp['lru_w_a'][0], lp['lru_b_a'][0], lp['lru_w_i'][0], lp['lru_b_i'][0], False)
    hb, hb_last = rglru_scan(xc, hb0, lp['lru_lambda'][1], lp['lru_w_a'][1], lp['lru_b_a'][1], lp['lru_w_i'][1], lp['lru_b_i'][1], True)
    ya = jax.nn.gelu(ga) * (hf + hb).astype(u.dtype)

    q = rms_norm(qg.reshape(b, t, GQA_HEADS, HEAD_DIM), lp['q_norm'])
    k = rms_norm(kg.reshape(b, t, GQA_KV_HEADS, HEAD_DIM), lp['k_norm'])
    v = vg.reshape(b, t, GQA_KV_HEADS, HEAD_DIM)

    qc = (rms_norm(cq, lp['mla_q_norm']) @ lp['mla_w_uq']).reshape(b, t, MLA_HEADS, MLA_NOPE_DIM + MLA_ROPE_DIM)
    qc_nope, qc_rope = qc[..., :MLA_NOPE_DIM], qc[..., MLA_NOPE_DIM:]
    ckv_n = rms_norm(ckv, lp['mla_kv_norm'])
    kr = kr[:, :, None, :]

    if ctx is None:
        k_att, v_att, ckv_att, kr_att = k, v, ckv_n, kr
    else:
        cos_g, sin_g = ropes[0]
        cos_m, sin_m = ropes[1]
        q = apply_rope(q, cos_g, sin_g)
        k_lat = apply_rope(k, cos_g, sin_g)
        qc_rope = apply_rope(qc_rope, cos_m, sin_m)
        kr_lat = apply_rope(kr, cos_m, sin_m)
        k_att = jnp.concatenate([ctx['k'].astype(k.dtype), k_lat], axis=1)
        v_att = jnp.concatenate([ctx['v'].astype(v.dtype), v], axis=1)
        ckv_att = jnp.concatenate([ctx['ckv'].astype(ckv_n.dtype), ckv_n], axis=1)
        kr_att = jnp.concatenate([ctx['krope'].astype(kr.dtype)[:, :, None, :], kr_lat], axis=1)

    yb = attention(q, k_att, v_att)

    s = ckv_att.shape[1]
    k_nope = (ckv_att @ lp['mla_w_uk']).reshape(b, s, MLA_HEADS, MLA_NOPE_DIM)
    v_c = (ckv_att @ lp['mla_w_uv']).reshape(b, s, MLA_HEADS, MLA_V_DIM)
    k_c = jnp.concatenate([k_nope, jnp.broadcast_to(kr_att, (b, s, MLA_HEADS, MLA_ROPE_DIM))], axis=-1)
    q_c = jnp.concatenate([qc_nope, qc_rope], axis=-1)
    yc = attention(q_c, k_c, v_c)

    y = jnp.concatenate([ya, yb, yc], axis=-1) @ lp['w_out']
    if ctx is None:
        return y, (k, v, ckv_n, kr[:, :, 0, :], jnp.stack([hf_last, hb_last], axis=1))
    return y, None


def trunk_layer(x, cond, lp, ropes, ctx):
    mod = (jax.nn.silu(cond) @ lp['w_mod'] + lp['b_mod'])[:, None, :]
    sh1, sc1, g1, sh2, sc2, g2, sh3, sc3, g3 = jnp.split(mod, N_MOD, axis=-1)
    x = layer_norm(DEEPNORM_ALPHA * x + 0.5 * g1 * swiglu(x * (1 + sc1) + sh1, lp, 0), lp['ln_g'][0], lp['ln_b'][0])
    y, ctx_out = mixer(x * (1 + sc2) + sh2, lp, ropes, ctx)
    x = layer_norm(DEEPNORM_ALPHA * x + g2 * y, lp['ln_g'][1], lp['ln_b'][1])
    x = layer_norm(DEEPNORM_ALPHA * x + 0.5 * g3 * swiglu(x * (1 + sc3) + sh3, lp, 1), lp['ln_g'][2], lp['ln_b'][2])
    return x, ctx_out


def setup_inputs(seed: int = 0) -> dict:
    key = jax.random.key(seed)
    ks = jax.random.split(key, 40)

    def nrm(k, shape, scale):
        return jax.random.normal(k, shape, F32) * scale

    L = DEPTH
    u_a = jax.random.uniform(ks[20], (L, 2, LRU_WIDTH), F32, minval=0.9, maxval=0.999)
    s_a = u_a ** (1.0 / LRU_C)
    lru_lambda = jnp.log(s_a) - jnp.log1p(-s_a)
    return {
        'x_prompt': nrm(ks[0], (BATCH, SEQ, D_MODEL), 1.0),
        'x_sample': nrm(ks[1], (DEC_BATCH, DEC_SEQ, D_MODEL), 1.0),
        'cache_gqa_k': nrm(ks[2], (DEC_BATCH, DEPTH, PAST_LEN, GQA_KV_HEADS, HEAD_DIM), 1.0),
        'cache_gqa_v': nrm(ks[3], (DEC_BATCH, DEPTH, PAST_LEN, GQA_KV_HEADS, HEAD_DIM), 1.0),
        'cache_mla_ckv': nrm(ks[4], (DEC_BATCH, DEPTH, PAST_LEN, MLA_KV_RANK), 1.0),
        'cache_mla_krope': nrm(ks[5], (DEC_BATCH, DEPTH, PAST_LEN, MLA_ROPE_DIM), 1.0),
        'state_lru': nrm(ks[6], (DEC_BATCH, DEPTH, 2, LRU_WIDTH), 0.5),
        'c': nrm(ks[7], (DEC_BATCH, D_MODEL), 1.0),
        'c_ctx': nrm(ks[8], (D_MODEL,), 1.0),
        'w_mod': nrm(ks[9], (L, D_MODEL, N_MOD * D_MODEL), 0.5 * D_MODEL ** -0.5),
        'b_mod': nrm(ks[10], (L, N_MOD * D_MODEL), 0.02),
        'ln_g': 1.0 + nrm(ks[11], (L, 3, D_MODEL), 0.02),
        'ln_b': nrm(ks[12], (L, 3, D_MODEL), 0.02),
        'ffn_w_gate': nrm(ks[13], (L, 2, D_MODEL, D_FF), D_MODEL ** -0.5),
        'ffn_w_up': nrm(ks[14], (L, 2, D_MODEL, D_FF), D_MODEL ** -0.5),
        'ffn_w_down': nrm(ks[15], (L, 2, D_FF, D_MODEL), DEEPNORM_BETA * D_FF ** -0.5),
        'w_in': nrm(ks[16], (L, D_MODEL, IN_COLS), D_MODEL ** -0.5),
        'w_out': nrm(ks[17], (L, MIX_WIDTH, D_MODEL), DEEPNORM_BETA * MIX_WIDTH ** -0.5),
        'lru_conv_w': nrm(ks[18], (L, CONV_W, LRU_WIDTH), CONV_W ** -0.5),
        'lru_conv_b': nrm(ks[19], (L, LRU_WIDTH), 0.02),
        'lru_w_a': nrm(ks[21], (L, 2, LRU_BLOCKS, LRU_BLOCK_W, LRU_BLOCK_W), LRU_BLOCK_W ** -0.5),
        'lru_b_a': nrm(ks[22], (L, 2, LRU_WIDTH), 0.02),
        'lru_w_i': nrm(ks[23], (L, 2, LRU_BLOCKS, LRU_BLOCK_W, LRU_BLOCK_W), LRU_BLOCK_W ** -0.5),
        'lru_b_i': nrm(ks[24], (L, 2, LRU_WIDTH), 0.02),
        'lru_lambda': lru_lambda,
        'gqa_q_norm': 1.0 + nrm(ks[25], (L, HEAD_DIM), 0.02),
        'gqa_k_norm': 1.0 + nrm(ks[26], (L, HEAD_DIM), 0.02),
        'mla_q_norm': 1.0 + nrm(ks[27], (L, MLA_Q_RANK), 0.02),
        'mla_w_uq': nrm(ks[28], (L, MLA_Q_RANK, MLA_HEADS * (MLA_NOPE_DIM + MLA_ROPE_DIM)), MLA_Q_RANK ** -0.5),
        'mla_kv_norm': 1.0 + nrm(ks[29], (L, MLA_KV_RANK), 0.02),
        'mla_w_uk': nrm(ks[30], (L, MLA_KV_RANK, MLA_HEADS * MLA_NOPE_DIM), MLA_KV_RANK ** -0.5),
        'mla_w_uv': nrm(ks[31], (L, MLA_KV_RANK, MLA_HEADS * MLA_V_DIM), MLA_KV_RANK ** -0.5),
    }


def reference(x_prompt, x_sample, cache_gqa_k, cache_gqa_v, cache_mla_ckv, cache_mla_krope, state_lru, c, c_ctx, w_mod, b_mod, ln_g, ln_b, ffn_w_gate, ffn_w_up, ffn_w_down, w_in, w_out, lru_conv_w, lru_conv_b, lru_w_a, lru_b_a, lru_w_i, lru_b_i, lru_lambda, gqa_q_norm, gqa_k_norm, mla_q_norm, mla_w_uq, mla_kv_norm, mla_w_uk, mla_w_uv):
    t_lat = x_sample.shape[1]
    ropes = (grid_rope(t_lat, HEAD_DIM), grid_rope(t_lat, MLA_ROPE_DIM))
    cond_ctx = c_ctx[None, :]
    xp, xs = x_prompt, x_sample
    new_k, new_v, new_ckv, new_kr, new_lru = [], [], [], [], []
    for l in range(DEPTH):
        lp = {
            'w_mod': w_mod[l], 'b_mod': b_mod[l], 'ln_g': ln_g[l], 'ln_b': ln_b[l],
            'ffn_w_gate': ffn_w_gate[l], 'ffn_w_up': ffn_w_up[l], 'ffn_w_down': ffn_w_down[l],
            'w_in': w_in[l], 'w_out': w_out[l],
            'conv_w': lru_conv_w[l], 'conv_b': lru_conv_b[l],
            'lru_w_a': lru_w_a[l], 'lru_b_a': lru_b_a[l], 'lru_w_i': lru_w_i[l], 'lru_b_i': lru_b_i[l], 'lru_lambda': lru_lambda[l],
            'q_norm': gqa_q_norm[l], 'k_norm': gqa_k_norm[l],
            'mla_q_norm': mla_q_norm[l], 'mla_w_uq': mla_w_uq[l], 'mla_kv_norm': mla_kv_norm[l],
            'mla_w_uk': mla_w_uk[l], 'mla_w_uv': mla_w_uv[l],
        }
        xp, (k_l, v_l, ckv_l, kr_l, lru_l) = trunk_layer(xp, cond_ctx, lp, ropes, None)
        new_k.append(k_l)
        new_v.append(v_l)
        new_ckv.append(ckv_l)
        new_kr.append(kr_l)
        new_lru.append(lru_l)
        ctx = {'k': cache_gqa_k[:, l], 'v': cache_gqa_v[:, l], 'ckv': cache_mla_ckv[:, l], 'krope': cache_mla_krope[:, l], 'lru': state_lru[:, l]}
        xs, _ = trunk_layer(xs, c, lp, ropes, ctx)
    return (xp, xs, jnp.stack(new_k, axis=1), jnp.stack(new_v, axis=1), jnp.stack(new_ckv, axis=1), jnp.stack(new_kr, axis=1), jnp.stack(new_lru, axis=1))
```

```cpp
#include <hip/hip_runtime.h>
#include <hip/hip_cooperative_groups.h>
#include <cstdio>
#include <cstdint>
namespace cg = cooperative_groups;

#ifndef MK_PER_PHASE_LAUNCH
#define MK_PER_PHASE_LAUNCH 0
#endif

#ifndef DUP_K
#define DUP_K -1
#endif
#ifndef DUP_SUB
#define DUP_SUB 31
#endif
#define LAS __attribute__((address_space(3)))
typedef unsigned short bf16_t;
typedef short bf16x8 __attribute__((ext_vector_type(8)));
typedef float f32x4 __attribute__((ext_vector_type(4)));
typedef float f32x2 __attribute__((ext_vector_type(2)));
typedef float f32x16 __attribute__((ext_vector_type(16)));
typedef unsigned u32x4 __attribute__((ext_vector_type(4)));
typedef unsigned u32x2 __attribute__((ext_vector_type(2)));
typedef int i32x4 __attribute__((ext_vector_type(4)));
typedef int i32x8 __attribute__((ext_vector_type(8)));

constexpr int DM = 1024, NTOK = 24576, NP = 8192, DFF = 2816, NLAYER = 4;
constexpr int SKV = 4352;
constexpr int NCKV = 25600;
constexpr int ZP = 1632;
constexpr float ALPHA = 1.681792830507429f;
constexpr float LOG2E = 1.4426950408889634f;
constexpr float C2G = 0.125f * LOG2E;
constexpr float C2C = 0.10206207261596575f * LOG2E;

constexpr size_t O_K = 25165824, O_V = 29360128, O_CKV = 33554432, O_KR = 37748736, O_LRU = 38797312;

constexpr size_t al256(size_t x) { return (x + 255) & ~(size_t)255; }
constexpr size_t WS_MOD = 0;
constexpr size_t WS_R64 = al256(WS_MOD + (size_t)4 * 5 * 9216 * 4);
constexpr size_t WS_R32 = WS_R64 + 64 * 16 * 8;
constexpr size_t WS_SPT = al256(WS_R32 + 64 * 8 * 8);
constexpr size_t WS_WGU = al256(WS_SPT + 4 * 512 * 4);
constexpr size_t WS_WD = WS_WGU + (size_t)2 * 5632 * 1024 * 2;
constexpr size_t WS_WIN = WS_WD + (size_t)2 * 1024 * 2816 * 2;
constexpr size_t WS_WOUT = WS_WIN + (size_t)1792 * 1024 * 2;
constexpr size_t WS_WLRU = WS_WOUT + (size_t)1024 * 1024 * 2;
constexpr size_t WS_WUQ = WS_WLRU + (size_t)1024 * 256 * 2;
constexpr size_t WS_WUKV = WS_WUQ + (size_t)512 * 256 * 2;
constexpr size_t WS_U = WS_WUKV + (size_t)512 * 256 * 2;
constexpr size_t WS_H = WS_U + (size_t)NTOK * 1024 * 2;
constexpr size_t WS_QG = WS_H + (size_t)NTOK * ZP * 4;
constexpr size_t WS_KG = WS_QG + (size_t)NTOK * 512 * 2;
constexpr size_t KG_S = (size_t)32 * 256 * 128;
constexpr size_t WS_VTG = WS_KG + (size_t)NCKV * 128 * 2;
constexpr size_t VTG_S = (size_t)64 * 64 * 256;
constexpr size_t WS_CQN = WS_VTG + (size_t)NCKV * 128 * 2;
constexpr size_t WS_CKV = WS_CQN + (size_t)NTOK * 256 * 2;
constexpr size_t WS_QC = WS_CKV + (size_t)NCKV * 256 * 2;
constexpr size_t WS_KC = WS_QC + (size_t)NTOK * 384 * 2;
constexpr size_t WS_VTC = WS_KC + (size_t)NCKV * 384 * 2;
constexpr size_t VTC_S = (size_t)128 * 64 * 256;
constexpr size_t WS_XCF = WS_VTC + (size_t)NCKV * 256 * 2;
constexpr size_t WS_XCB = WS_XCF + (size_t)NTOK * 256 * 4;
constexpr size_t WS_A = WS_H;
constexpr size_t WS_UU = WS_A + (size_t)NTOK * 512 * 4;
constexpr size_t WS_HF = WS_UU + (size_t)NTOK * 512 * 4;
constexpr size_t WS_HB = WS_HF + (size_t)NTOK * 256 * 4;
static_assert(WS_HB + (size_t)NTOK * 256 * 4 <= WS_H + (size_t)NTOK * ZP * 4, "scan buffers fit in the Z region");
constexpr size_t WS_GA = WS_XCB + (size_t)NTOK * 256 * 2;
constexpr size_t WS_ST = WS_GA + (size_t)NTOK * 256 * 4;
constexpr size_t WS_LNG = WS_ST + (size_t)NTOK * 8;
constexpr size_t WS_BAR = WS_LNG + (size_t)2 * 12 * 1024 * 4;
constexpr size_t WS_END = WS_BAR + 16384;
static_assert((size_t)NTOK * DFF * 2 <= (size_t)NTOK * ZP * 4, "H fits in the Z region");

constexpr int LDS_BYTES = 147456;

struct Params {
    const float* in[32];
    float* out;
    unsigned char* ws;
    int ph_lo, ph_hi;
};

__device__ __forceinline__ const float* INP(const Params& p, int i) { asm volatile("" : "+s"(i)); return p.in[i]; }
__device__ __forceinline__ unsigned f2bf(float f) { unsigned u = __builtin_bit_cast(unsigned, f); return (u + 0x7fffu + ((u >> 16) & 1u)) >> 16; }
typedef __bf16 bf16x2_t __attribute__((ext_vector_type(2)));
__device__ __forceinline__ unsigned pk2(float lo, float hi) { const f32x2 v = {lo, hi}; const bf16x2_t b = __builtin_convertvector(v, bf16x2_t); return __builtin_bit_cast(unsigned, b); }
__device__ __forceinline__ f32x4 bf4(u32x2 w) { return (f32x4){__builtin_bit_cast(float, w.x << 16), __builtin_bit_cast(float, w.x & 0xffff0000u), __builtin_bit_cast(float, w.y << 16), __builtin_bit_cast(float, w.y & 0xffff0000u)}; }
__device__ __forceinline__ unsigned pk4_fp8(float a, float b, float c, float d) {
    int w = __builtin_amdgcn_cvt_pk_fp8_f32(a, b, 0, false); w = __builtin_amdgcn_cvt_pk_fp8_f32(c, d, w, true); return (unsigned)w; }
constexpr float WGU_SCALE = 32.f, WD_SCALE = 128.f;
__device__ __forceinline__ float siluf(float x) { return x * __builtin_amdgcn_rcpf(1.f + __expf(-x)); }
__device__ __forceinline__ float sigmoidf_(float x) { return __builtin_amdgcn_rcpf(1.f + __expf(-x)); }
__device__ __forceinline__ float gelu_tanh(float x) {
    const float y = 0.7978845608028654f * (x + 0.044715f * x * x * x);
    const float e = __expf(2.f * y);
    const float th = 1.f - 2.f * __builtin_amdgcn_rcpf(e + 1.f);
    return 0.5f * x * (1.f + th);
}
__device__ __forceinline__ int obx() { int b = blockIdx.x; asm volatile("" : "+s"(b)); return b; }
__device__ __forceinline__ int ogd() { int b = gridDim.x; asm volatile("" : "+s"(b)); return b; }
__device__ __forceinline__ int olane() { int l; asm volatile("v_mbcnt_lo_u32_b32 %0, -1, 0\n\tv_mbcnt_hi_u32_b32 %0, -1, %0" : "=v"(l)); return l; }
__device__ __forceinline__ int otid(int wv) { int l; asm volatile("v_mbcnt_lo_u32_b32 %0, -1, 0\n\tv_mbcnt_hi_u32_b32 %0, -1, %0" : "=v"(l)); return wv * 64 + l; }
__device__ __forceinline__ float shx(float v, int mask, int lane) { return __builtin_bit_cast(float, __builtin_amdgcn_ds_bpermute((lane ^ mask) << 2, __builtin_bit_cast(int, v))); }
__device__ __forceinline__ float wave_sum(float v, int lane) {
#pragma unroll
    for (int o = 1; o < 64; o <<= 1) v += shx(v, o, lane);
    return v;
}
__device__ __forceinline__ float ozero() { float z = 0.f; asm volatile("" : "+v"(z)); return z; }

namespace pg8 {
constexpr int BM = 256, BK = 64, HALF = 128, HTB = HALF * BK * 2, STAGE_BYTES = 8 * HTB, NXCD = 8, WGM = 8;
__host__ __device__ __forceinline__ int lds_byte(int r, int c) { const int st = (r >> 4) * 2 + (c >> 5), rr = r & 15, cc = c & 31, ob = rr * 64 + cc * 2; return st * 1024 + (ob ^ (((ob >> 9) & 1) << 5)); }
__host__ __device__ __forceinline__ void stage_rc(int b, int& R, int& C) { const int st = b / 1024, sb = b % 1024, swz = sb ^ (((sb >> 9) & 1) << 5); R = (st >> 1) * 16 + swz / 64; C = (st & 1) * 32 + (swz % 64) / 2; }
__host__ __device__ __forceinline__ int perm32(int rho) { const int n = rho >> 4, i = rho & 15; return 8 * (i >> 2) + 4 * n + (i & 3); }
struct Unit { int pm, pn; };
struct Gemm { const bf16_t* A; const bf16_t* Bt; int M, N, K; };
struct StaticOrder {
    int nM, nN, nwg, G, c;
    __device__ __forceinline__ void init(int M, int N, int G_, int c_) { nM = M / BM; nN = N / BM; nwg = nM * nN; G = G_; c = c_; }
    __device__ __forceinline__ bool next(int i, Unit& u) const {
        const long L = (long)i * G + c; if (L >= nwg) return false;
        int wgid = (int)L; { const int q = nwg / NXCD, r = nwg % NXCD, xcd = wgid % NXCD, off = wgid / NXCD; wgid = (xcd < r ? xcd * (q + 1) : r * (q + 1) + (xcd - r) * q) + off; }
        const int nig = WGM * nN, gid = wgid / nig, fm = gid * WGM, gsz = (nM - fm) < WGM ? (nM - fm) : WGM;
        u.pm = fm + ((wgid % nig) % gsz); u.pn = (wgid % nig) / gsz; return true;
    }
};

__device__ __forceinline__ void glds16s(const void* sbase, unsigned voff, unsigned lds_dst) {
    unsigned keep;
    asm volatile("s_mov_b32 %0, m0\n\ts_mov_b32 m0, %3\n\ts_nop 0\n\tglobal_load_lds_dwordx4 %1, %2\n\ts_mov_b32 m0, %0" : "=&s"(keep) : "v"(voff), "s"(sbase), "s"(lds_dst) : "memory");
}
template <class Epi, bool FP8 = false>
__device__ __forceinline__ void gemm_phase(int wv, LAS unsigned char* lds, const Gemm g, const StaticOrder& S, const Epi& E) {
    const int tid = otid(wv), wid = __builtin_amdgcn_readfirstlane(tid >> 6), lane = tid & 63, wr = wid >> 2, wc = wid & 3, fr = lane & 15, fq = lane >> 4;
    const int K = g.K, nt = K / BK;
    unsigned voffA[2], voffB[2];
#pragma unroll
    for (int i = 0; i < 2; ++i) { int R, C; stage_rc(tid * 16 + i * 8192, R, C); const int Rb = Epi::PERM ? ((R & ~31) + perm32(R & 31)) : R;
        voffA[i] = (unsigned)(R * K + C) * 2u; voffB[i] = (unsigned)(Rb * K + C) * 2u; }
    const size_t kstep = (size_t)(BK * 2);
    const size_t hstep = (size_t)HALF * K * 2;
    const size_t tstep = 2 * hstep;
    const unsigned lds0 = (unsigned)__builtin_amdgcn_readfirstlane((int)((unsigned)(__UINTPTR_TYPE__)lds + (unsigned)wid * 1024u));
    const int aoff = lds_byte(wr * 64 + fr, fq * 8), boff = lds_byte(wc * 32 + fr, fq * 8);
#define PG8_SA(b, h) (((b) * 2 + (h)) * HTB)
#define PG8_SB(b, h) ((4 + (b) * 2 + (h)) * HTB)
#define PG8_STAGE(bufoff, gbase, voff) do { _Pragma("unroll") for (int _i = 0; _i < 2; ++_i) \
        glds16s((const void*)(gbase), (voff)[_i], lds0 + (unsigned)((bufoff) + _i * 8192)); } while (0)
#define PG8_LDA(dst, b, h) do { _Pragma("unroll") for (int m = 0; m < 4; ++m) _Pragma("unroll") for (int k = 0; k < 2; ++k) dst[m][k] = *(const LAS bf16x8*)(lds + PG8_SA(b, h) + aoff + m * 2048 + k * 1024); } while (0)
#define PG8_LDB(dst, b, h) do { _Pragma("unroll") for (int n = 0; n < 2; ++n) _Pragma("unroll") for (int k = 0; k < 2; ++k) dst[n][k] = *(const LAS bf16x8*)(lds + PG8_SB(b, h) + boff + n * 2048 + k * 1024); } while (0)
#define PG8_MMA(ai, bj, At, Bt) do { __builtin_amdgcn_s_setprio(1); _Pragma("unroll") for (int m = 0; m < 4; ++m) _Pragma("unroll") for (int n = 0; n < 2; ++n) { \
        if constexpr (FP8) { \
            const i32x8 b8_ = __builtin_shufflevector(__builtin_bit_cast(i32x4, Bt[n][0]), __builtin_bit_cast(i32x4, Bt[n][1]), 0, 1, 2, 3, 4, 5, 6, 7); \
            const i32x8 a8_ = __builtin_shufflevector(__builtin_bit_cast(i32x4, At[m][0]), __builtin_bit_cast(i32x4, At[m][1]), 0, 1, 2, 3, 4, 5, 6, 7); \
            acc[ai][bj][m][n] = __builtin_amdgcn_mfma_scale_f32_16x16x128_f8f6f4(b8_, a8_, acc[ai][bj][m][n], 0, 0, 0, 0, 0, 0); \
        } else { _Pragma("unroll") for (int k = 0; k < 2; ++k) \
            acc[ai][bj][m][n] = __builtin_amdgcn_mfma_f32_16x16x32_bf16(Bt[n][k], At[m][k], acc[ai][bj][m][n], 0, 0, 0); } } \
        __builtin_amdgcn_s_setprio(0); } while (0)
#define PG8_WAIT_V(n) asm volatile("s_waitcnt vmcnt(" #n ")" ::: "memory")
#define PG8_WAIT_L(n) asm volatile("s_waitcnt lgkmcnt(" #n ")" ::: "memory")
#define PG8_BAR __builtin_amdgcn_s_barrier()
#define PG8_SCHED __builtin_amdgcn_sched_barrier(0)
    Unit cur, nxt; int ui = 0;
    if (!S.next(0, cur)) return;
    f32x4 acc[2][2][4][2];
    { const float z = ozero();
#pragma unroll
    for (int a = 0; a < 2; ++a)
#pragma unroll
        for (int b = 0; b < 2; ++b)
#pragma unroll
            for (int m = 0; m < 4; ++m)
#pragma unroll
                for (int n = 0; n < 2; ++n) acc[a][b][m][n] = (f32x4){z, z, z, z}; }
    bf16x8 At[4][2], B0[2][2], B1[2][2];
    const char* cA = (const char*)g.A + (size_t)cur.pm * tstep; const char* cB = (const char*)g.Bt + (size_t)cur.pn * tstep;
    PG8_STAGE(PG8_SB(0, 0), cB, voffB); PG8_STAGE(PG8_SA(0, 0), cA, voffA); PG8_STAGE(PG8_SB(0, 1), cB + hstep, voffB); PG8_STAGE(PG8_SA(0, 1), cA + hstep, voffA);
    if (wr == 1) PG8_BAR;
    PG8_WAIT_V(4); PG8_BAR;
    PG8_STAGE(PG8_SB(1, 0), cB + kstep, voffB); PG8_STAGE(PG8_SA(1, 0), cA + kstep, voffA); PG8_STAGE(PG8_SB(1, 1), cB + hstep + kstep, voffB);
    PG8_WAIT_V(6); PG8_BAR;
    for (;;) {
        const bool has_next = S.next(ui + 1, nxt);
        const char* nA = has_next ? (const char*)g.A + (size_t)nxt.pm * tstep : cA; const char* nB = has_next ? (const char*)g.Bt + (size_t)nxt.pn * tstep : cB;
        for (int t = 0; t < nt; t += 2) {
            const bool last = (t == nt - 2);
            const char* a1 = cA + (size_t)(t + 1) * kstep;
            const char* a2 = last ? nA : cA + (size_t)(t + 2) * kstep; const char* b2 = last ? nB : cB + (size_t)(t + 2) * kstep;
            const char* a3 = a2 + kstep; const char* b3 = b2 + kstep;
            PG8_LDB(B0, 0, 0); PG8_SCHED; PG8_LDA(At, 0, 0); PG8_STAGE(PG8_SA(1, 1), a1 + hstep, voffA);
            PG8_WAIT_L(8); PG8_BAR; PG8_WAIT_L(0); PG8_MMA(0, 0, At, B0); PG8_BAR; PG8_SCHED;
            PG8_LDB(B1, 0, 1); PG8_STAGE(PG8_SB(0, 0), b2, voffB);
            PG8_BAR; PG8_WAIT_L(0); PG8_MMA(0, 1, At, B1); PG8_BAR;
            PG8_LDA(At, 0, 1); PG8_STAGE(PG8_SA(0, 0), a2, voffA);
            PG8_BAR; PG8_WAIT_L(0); PG8_MMA(1, 0, At, B0); PG8_BAR; PG8_SCHED;
            PG8_STAGE(PG8_SB(0, 1), b2 + hstep, voffB);
            PG8_WAIT_V(6); PG8_BAR; PG8_MMA(1, 1, At, B1); PG8_BAR;
            PG8_LDB(B0, 1, 0); PG8_SCHED; PG8_LDA(At, 1, 0); PG8_STAGE(PG8_SA(0, 1), a2 + hstep, voffA);
            PG8_WAIT_L(8); PG8_BAR; PG8_WAIT_L(0); PG8_MMA(0, 0, At, B0); PG8_BAR; PG8_SCHED;
            PG8_LDB(B1, 1, 1); PG8_STAGE(PG8_SB(1, 0), b3, voffB);
            PG8_BAR; PG8_WAIT_L(0); PG8_MMA(0, 1, At, B1); PG8_BAR;
            PG8_LDA(At, 1, 1); PG8_STAGE(PG8_SA(1, 0), a3, voffA);
            PG8_BAR; PG8_WAIT_L(0); PG8_MMA(1, 0, At, B0); PG8_BAR; PG8_SCHED;
            PG8_STAGE(PG8_SB(1, 1), b3 + hstep, voffB);
            PG8_WAIT_V(6); PG8_BAR; PG8_MMA(1, 1, At, B1); PG8_BAR;
        }
        E(acc, cur, wr, wc, fr, fq);
        if (!has_next) break;
        { const float z = ozero();
#pragma unroll
        for (int a = 0; a < 2; ++a)
#pragma unroll
            for (int b = 0; b < 2; ++b)
#pragma unroll
                for (int m = 0; m < 4; ++m)
#pragma unroll
                    for (int n = 0; n < 2; ++n) acc[a][b][m][n] = (f32x4){z, z, z, z}; }
        cur = nxt; cA = nA; cB = nB; ++ui;
    }
    PG8_WAIT_V(0);
    if (wr == 0) PG8_BAR;
    PG8_BAR;
#undef PG8_SA
#undef PG8_SB
#undef PG8_STAGE
#undef PG8_LDA
#undef PG8_LDB
#undef PG8_MMA
#undef PG8_WAIT_V
#undef PG8_WAIT_L
#undef PG8_BAR
#undef PG8_SCHED
}
}

typedef const f32x4 (&AccRef)[2][2][4][2];

struct EpiSwiGLU {
    static constexpr bool PERM = true;
    unsigned char* H;
    __device__ __forceinline__ void operator()(AccRef acc, const pg8::Unit& u, int wr, int wc, int fr, int fq) const {
        { const int l_ = olane(); fr = l_ & 15; fq = l_ >> 4; }
        const int row0 = u.pm * 256 + wr * 64 + fr, col0 = u.pn * 128 + wc * 32 + 8 * fq;
        constexpr float IS = 1.f / WGU_SCALE;
#pragma unroll
        for (int ai = 0; ai < 2; ++ai)
#pragma unroll
            for (int m = 0; m < 4; ++m) {
                unsigned char* rowp = H + (size_t)(row0 + ai * 128 + m * 16) * DFF + col0;
                const f32x4 g0 = acc[ai][0][m][0] * IS, g1 = acc[ai][0][m][1] * IS, u0 = acc[ai][1][m][0] * IS, u1 = acc[ai][1][m][1] * IS;
                u32x2 w;
                w.x = pk4_fp8(siluf(g0[0]) * u0[0], siluf(g0[1]) * u0[1], siluf(g0[2]) * u0[2], siluf(g0[3]) * u0[3]);
                w.y = pk4_fp8(siluf(g1[0]) * u1[0], siluf(g1[1]) * u1[1], siluf(g1[2]) * u1[2], siluf(g1[3]) * u1[3]);
                *(u32x2*)rowp = w;
            }
    }
};
struct EpiResid {
    static constexpr bool PERM = false;
    float* X; const float* modl; const float* st; int gidx; float gs; int lnix; int pad_;
    __device__ __forceinline__ void operator()(AccRef acc, const pg8::Unit& u, int wr, int wc, int fr, int fq) const {
        { const int l_ = olane(); fr = l_ & 15; fq = l_ >> 4; }
        const int row0 = u.pm * 256 + wr * 64 + fr, col0 = u.pn * 256 + wc * 32 + 4 * fq;
        const int grp = u.pm < 32 ? 0 : 1 + ((u.pm - 32) >> 4);
        const float* gp = modl + grp * 9216 + gidx * 1024 + col0;
        f32x4 gv[2][2], gl[2][2], bl[2][2];
        const int idn = lnix < 0; const float* lg = st + (WS_LNG - WS_ST) / 4 + (idn ? 0 : lnix) * 1024; const float* lb = lg + 12 * 1024;
#pragma unroll
        for (int bj = 0; bj < 2; ++bj)
#pragma unroll
            for (int n = 0; n < 2; ++n) { gv[bj][n] = *(const f32x4*)(gp + bj * 128 + n * 16) * gs;
                gl[bj][n] = *(const f32x4*)(lg + col0 + bj * 128 + n * 16) * ALPHA; if (idn) gl[bj][n] = (f32x4){ALPHA, ALPHA, ALPHA, ALPHA};
                bl[bj][n] = *(const f32x4*)(lb + col0 + bj * 128 + n * 16) * ALPHA; if (idn) bl[bj][n] = (f32x4){0.f, 0.f, 0.f, 0.f}; }
#pragma unroll
        for (int ai = 0; ai < 2; ++ai)
#pragma unroll
            for (int m = 0; m < 4; ++m) {
                const int row = row0 + ai * 128 + m * 16;
                const f32x2 ms = *(const f32x2*)(st + 2 * (size_t)row);
                float* rowp = X + (size_t)row * DM + col0;
#pragma unroll
                for (int bj = 0; bj < 2; ++bj)
#pragma unroll
                    for (int n = 0; n < 2; ++n) { f32x4* q = (f32x4*)(rowp + bj * 128 + n * 16); *q = ((*q - ms.x) * ms.y) * gl[bj][n] + bl[bj][n] + gv[bj][n] * acc[ai][bj][m][n]; }
            }
    }
};
struct EpiDiscard {
    static constexpr bool PERM = false;
    float* sink;
    __device__ __forceinline__ void operator()(AccRef acc, const pg8::Unit& u, int wr, int wc, int fr, int fq) const {
        f32x4 t = acc[0][0][0][0];
#pragma unroll
        for (int ai = 0; ai < 2; ++ai)
#pragma unroll
            for (int bj = 0; bj < 2; ++bj)
#pragma unroll
                for (int m = 0; m < 4; ++m)
#pragma unroll
                    for (int n = 0; n < 2; ++n) t = t + acc[ai][bj][m][n];
        if (t.x + t.y + t.z + t.w == 1.2345678e33f) *sink = t.x;
    }
};
struct EpiZ {
    static constexpr bool PERM = true;
    bf16_t* Z;
    __device__ __forceinline__ void operator()(AccRef acc, const pg8::Unit& u, int wr, int wc, int fr, int fq) const {
        { const int l_ = olane(); fr = l_ & 15; fq = l_ >> 4; }
        const int row0 = u.pm * 256 + wr * 64 + fr, col0 = u.pn * 256 + wc * 32 + 8 * fq;
#pragma unroll
        for (int ai = 0; ai < 2; ++ai)
#pragma unroll
            for (int m = 0; m < 4; ++m) {
                bf16_t* rowp = Z + (size_t)(row0 + ai * 128 + m * 16) * ZP + col0;
#pragma unroll
                for (int bj = 0; bj < 2; ++bj) if (col0 + bj * 128 < ZP) {
                    const f32x4 v0 = acc[ai][bj][m][0], v1 = acc[ai][bj][m][1];
                    u32x4 w; w.x = pk2(v0[0], v0[1]); w.y = pk2(v0[2], v0[3]); w.z = pk2(v1[0], v1[1]); w.w = pk2(v1[2], v1[3]);
                    *(u32x4*)(rowp + bj * 128) = w; }
            }
    }
};
struct EpiLru {
    static constexpr bool PERM = false;
    const bf16_t* xcb; bf16_t* A; bf16_t* U; const float* ba; const float* bi; const float* lam;
    __device__ __forceinline__ void operator()(AccRef acc, const pg8::Unit& u, int wr, int wc, int fr, int fq) const {
        { const int l_ = olane(); fr = l_ & 15; fq = l_ >> 4; }
        const int row0 = u.pm * 256 + wr * 64 + fr;
#pragma unroll
        for (int n = 0; n < 2; ++n) {
            const int combo = u.pn * 128 + wc * 32 + 16 * n + 4 * fq, ch = combo & 255;
            const f32x4 bav = *(const f32x4*)(ba + combo), biv = *(const f32x4*)(bi + combo), sp = *(const f32x4*)(lam + combo);
#pragma unroll
            for (int ai = 0; ai < 2; ++ai)
#pragma unroll
                for (int m = 0; m < 4; ++m) {
                    const size_t row = (size_t)(row0 + ai * 128 + m * 16);
                    const f32x4 xc = bf4(*(const u32x2*)(xcb + row * 256 + ch));
                    const f32x4 ra = acc[ai][0][m][n], ri = acc[ai][1][m][n];
                    f32x4 av, uv;
#pragma unroll
                    for (int j = 0; j < 4; ++j) {
                        const float r = sigmoidf_(ra[j] + bav[j]), ig = sigmoidf_(ri[j] + biv[j]);
                        const float la = r * sp[j];
                        const float ea = __expf(la);
                        const float x2 = 2.f * la;
                        const float om = (x2 > -0.1f) ? -x2 * (1.f + 0.5f * x2 * (1.f + (1.f / 3.f) * x2 * (1.f + 0.25f * x2 * (1.f + 0.2f * x2)))) : 1.f - ea * ea;
                        av[j] = (la > -0.1f) ? -la * (1.f + 0.5f * la * (1.f + (1.f / 3.f) * la * (1.f + 0.25f * la))) : 1.f - ea;
                        uv[j] = sqrtf(om) * ig * xc[j];
                    }
                    { const size_t ai_ = (((size_t)(combo >> 3) * NTOK + row) << 3) + (combo & 7); { u32x2 aw; aw.x = pk2(av[0], av[1]); aw.y = pk2(av[2], av[3]); *(u32x2*)(A + ai_) = aw; } u32x2 uw; uw.x = pk2(uv[0], uv[1]); uw.y = pk2(uv[2], uv[3]); *(u32x2*)(U + ai_) = uw; }
                    asm volatile("" ::: "memory");
                }
        }
    }
};
struct EpiQc {
    static constexpr bool PERM = false;
    bf16_t* Qc; const f32x2* r32t;
    __device__ __forceinline__ void operator()(AccRef acc, const pg8::Unit& u, int wr, int wc, int fr, int fq) const {
        { const int l_ = olane(); fr = l_ & 15; fq = l_ >> 4; }
        const int row0 = u.pm * 256 + wr * 64 + fr;
#pragma unroll
        for (int bj = 0; bj < 2; ++bj) {
            const int G = u.pn * 8 + bj * 4 + wc;
            if (G >= 12) continue;
            const bool isrope = (G % 3) == 2;
#pragma unroll
            for (int ai = 0; ai < 2; ++ai)
#pragma unroll
                for (int m = 0; m < 4; ++m) {
                    const int row = row0 + ai * 128 + m * 16;
                    f32x4 x0 = acc[ai][bj][m][0], x1 = acc[ai][bj][m][1];
                    if (isrope && row >= NP) {
                        const int t = (row - NP) & 4095; const int pos = (fq < 2) ? (t >> 6) : (t & 63);
                        const f32x2* cs = r32t + pos * 8 + 4 * (fq & 1);
#pragma unroll
                        for (int j = 0; j < 4; ++j) { const f32x2 c = cs[j]; const float a = x0[j], b = x1[j]; x0[j] = a * c.x - b * c.y; x1[j] = a * c.y + b * c.x; }
                    }
                    bf16_t* op = Qc + (size_t)row * 384 + G * 32 + 4 * fq;
                    u32x2 w0, w1; w0.x = pk2(x0[0] * C2C, x0[1] * C2C); w0.y = pk2(x0[2] * C2C, x0[3] * C2C); w1.x = pk2(x1[0] * C2C, x1[1] * C2C); w1.y = pk2(x1[2] * C2C, x1[3] * C2C);
                    *(u32x2*)op = w0; *(u32x2*)(op + 16) = w1;
                    asm volatile("" ::: "memory");
                }
        }
    }
};
struct EpiKv {
    static constexpr bool PERM = false;
    bf16_t* Kc; bf16_t* Vtc;
    __device__ __forceinline__ void operator()(AccRef acc, const pg8::Unit& u, int wr, int wc, int fr, int fq) const {
        { const int l_ = olane(); fr = l_ & 15; fq = l_ >> 4; }
        const int rl = wr * 64 + fr;
        if (u.pn == 0) {
            bf16_t* kb = Kc + ((size_t)u.pm * 256 + rl) * 384 + 4 * fq;
#pragma unroll
            for (int ai = 0; ai < 2; ++ai)
#pragma unroll
                for (int m = 0; m < 4; ++m)
#pragma unroll
                    for (int bj = 0; bj < 2; ++bj)
#pragma unroll
                        for (int n = 0; n < 2; ++n) {
                            const int c = bj * 128 + wc * 32 + 16 * n, h = c >> 6, e = c & 63;
                            const f32x4 v = acc[ai][bj][m][n];
                            u32x2 w; w.x = pk2(v[0], v[1]); w.y = pk2(v[2], v[3]);
                            *(u32x2*)(kb + (size_t)(ai * 128 + m * 16) * 384 + h * 96 + e) = w;
                        }
        } else {
            bf16_t* vb = Vtc + ((size_t)u.pm * 256 + rl) * 256 + 4 * fq;
#pragma unroll
            for (int ai = 0; ai < 2; ++ai)
#pragma unroll
                for (int m = 0; m < 4; ++m)
#pragma unroll
                    for (int bj = 0; bj < 2; ++bj)
#pragma unroll
                        for (int n = 0; n < 2; ++n) {
                            const f32x4 v = acc[ai][bj][m][n];
                            u32x2 w; w.x = pk2(v[0], v[1]); w.y = pk2(v[2], v[3]);
                            *(u32x2*)(vb + (size_t)(ai * 128 + m * 16) * 256 + bj * 128 + wc * 32 + 16 * n) = w;
                        }
        }
    }
};

__device__ __forceinline__ float max3f(float a, float b, float c) { float r; asm("v_max3_f32 %0, %1, %2, %3" : "=v"(r) : "v"(a), "v"(b), "v"(c)); return r; }
__device__ __forceinline__ float max2f(float a, float b) { float r; asm("v_max_f32_e32 %0, %1, %2" : "=v"(r) : "v"(a), "v"(b)); return r; }
template <int DQ>
__device__ __forceinline__ void attn_unit(int wv, LAS unsigned char* lds, const bf16_t* Qp, int qpitch, const bf16_t* Kp, int kpitch, const bf16_t* Vp, int vpitch, int S, bf16_t* Op, int opitch) {
    constexpr int KROW = DQ * 2 + 16, VROW = 192, KT = 64 * KROW, VT = 64 * VROW, KCH = DQ / 8, ND = DQ / 16;
    const int tid = otid(wv), lane = tid & 63, wid = tid >> 6, r32 = lane & 31, hi = lane >> 5;
    const bf16_t* qrow = Qp + (size_t)(wid * 32 + r32) * qpitch;
    bf16x8 qr[ND];
#pragma unroll
    for (int d0 = 0; d0 < ND; ++d0) qr[d0] = *(const bf16x8*)(qrow + d0 * 16 + hi * 8);
    const int krow0 = tid / KCH, kch0 = tid % KCH;
    const int krow1 = (tid + 512) / KCH, kch1 = (tid + 512) % KCH;
    const bool k2 = (DQ > 64) && (tid + 512 < 64 * KCH);
    const int vrow = tid >> 3, vch = tid & 7;
    const bf16_t* ksrc0 = Kp + (size_t)krow0 * kpitch + kch0 * 8;
    const bf16_t* ksrc1 = Kp + (size_t)krow1 * kpitch + kch1 * 8;
    const bf16_t* vsrc = Vp + (size_t)vrow * vpitch + vch * 8;
    const int kdst0 = krow0 * KROW + kch0 * 16, kdst1 = krow1 * KROW + kch1 * 16, vdst = 2 * KT + vrow * VROW + vch * 16;
    const int pr = (r32 & ~12) | ((r32 & 4) << 1) | ((r32 & 8) >> 1);
    const int kaddr = pr * KROW + hi * 16, vaddr = 2 * KT + (8 * hi + ((lane & 15) >> 2)) * VROW + (16 * ((lane >> 4) & 1) + 4 * (lane & 3)) * 2;
    const int NT = S / 64;
    u32x4 kr0, kr1 = (u32x4){0, 0, 0, 0}, vr;
    kr0 = *(const u32x4*)ksrc0; if (k2) kr1 = *(const u32x4*)ksrc1; vr = *(const u32x4*)vsrc;
    *(LAS u32x4*)(lds + kdst0) = kr0; if (k2) *(LAS u32x4*)(lds + kdst1) = kr1; *(LAS u32x4*)(lds + vdst) = vr;
    kr0 = *(const u32x4*)(ksrc0 + (size_t)64 * kpitch); if (k2) kr1 = *(const u32x4*)(ksrc1 + (size_t)64 * kpitch);
    *(LAS u32x4*)(lds + KT + kdst0) = kr0; if (k2) *(LAS u32x4*)(lds + KT + kdst1) = kr1;
    __syncthreads();
    float mref = 0.f, lrun = 0.f;
    f32x16 o0 = {}, o1 = {}, p0 = {}, p1 = {}, negm = {};
#pragma unroll
    for (int d0 = 0; d0 < ND; ++d0) {
        const bf16x8 ka = *(const LAS bf16x8*)(lds + kaddr + d0 * 32);
        const bf16x8 kb = *(const LAS bf16x8*)(lds + kaddr + 32 * KROW + d0 * 32);
        p0 = __builtin_amdgcn_mfma_f32_32x32x16_bf16(ka, qr[d0], p0, 0, 0, 0);
        p1 = __builtin_amdgcn_mfma_f32_32x32x16_bf16(kb, qr[d0], p1, 0, 0, 0);
    }
#pragma unroll 2
    for (int t = 0; t < NT; ++t) {
        const int cur = t & 1;
        const bool more1 = (t + 1 < NT), more2 = (t + 2 < NT);
        if (more2) { kr0 = *(const u32x4*)(ksrc0 + (size_t)(t + 2) * 64 * kpitch); if (k2) kr1 = *(const u32x4*)(ksrc1 + (size_t)(t + 2) * 64 * kpitch); }
        if (more1) vr = *(const u32x4*)(vsrc + (size_t)(t + 1) * 64 * vpitch);
        float rm = max3f(p0[0], p1[0], p0[1]);
        rm = max3f(rm, p1[1], p0[2]);
#pragma unroll
        for (int r = 2; r < 15; ++r) rm = max3f(rm, p1[r], p0[r + 1]);
        rm = max2f(rm, p1[15]);
        rm = max2f(rm, shx(rm, 32, lane));
        if (t == 0 || __builtin_amdgcn_ballot_w64(rm > 10.f) != 0ull) {
            const float dl = (t == 0) ? rm : max2f(rm, 0.f);
            mref += dl;
            const float al = __builtin_amdgcn_exp2f(-dl);
            lrun *= al;
#pragma unroll
            for (int r = 0; r < 16; ++r) { o0[r] *= al; o1[r] *= al; p0[r] -= dl; p1[r] -= dl; negm[r] = -mref; }
        }
        f32x16 n0 = negm, n1 = negm;
        {
            __builtin_amdgcn_s_setprio(1);
            LAS unsigned char* kb_ = lds + (cur ^ 1) * KT;
#pragma unroll
            for (int d0 = 0; d0 < ND; ++d0) {
                const bf16x8 ka = *(const LAS bf16x8*)(kb_ + kaddr + d0 * 32);
                const bf16x8 kb = *(const LAS bf16x8*)(kb_ + kaddr + 32 * KROW + d0 * 32);
                n0 = __builtin_amdgcn_mfma_f32_32x32x16_bf16(ka, qr[d0], n0, 0, 0, 0);
                n1 = __builtin_amdgcn_mfma_f32_32x32x16_bf16(kb, qr[d0], n1, 0, 0, 0);
            }
        }
        __builtin_amdgcn_s_setprio(0);
        float ls = 0.f;
#pragma unroll
        for (int r = 0; r < 16; ++r) { p0[r] = __builtin_amdgcn_exp2f(p0[r]); p1[r] = __builtin_amdgcn_exp2f(p1[r]); ls += p0[r] + p1[r]; }
        lrun += ls;
#pragma unroll
        for (int i_ = 0; i_ < 2 * ND; ++i_) { __builtin_amdgcn_sched_group_barrier(0x008, 1, 0); __builtin_amdgcn_sched_group_barrier(0x002, 64 / (2 * ND) + 2, 0); }
        bf16x8 pp[4];
#pragma unroll
        for (int s2 = 0; s2 < 2; ++s2) {
            u32x4 w; w.x = pk2(p0[8 * s2 + 0], p0[8 * s2 + 1]); w.y = pk2(p0[8 * s2 + 2], p0[8 * s2 + 3]); w.z = pk2(p0[8 * s2 + 4], p0[8 * s2 + 5]); w.w = pk2(p0[8 * s2 + 6], p0[8 * s2 + 7]);
            pp[s2] = __builtin_bit_cast(bf16x8, w);
            u32x4 w2; w2.x = pk2(p1[8 * s2 + 0], p1[8 * s2 + 1]); w2.y = pk2(p1[8 * s2 + 2], p1[8 * s2 + 3]); w2.z = pk2(p1[8 * s2 + 4], p1[8 * s2 + 5]); w2.w = pk2(p1[8 * s2 + 6], p1[8 * s2 + 7]);
            pp[2 + s2] = __builtin_bit_cast(bf16x8, w2);
        }
        {
            LAS unsigned char* vb_ = lds + cur * VT;
#pragma unroll
            for (int s2 = 0; s2 < 4; ++s2) {
                typedef short v4i16_t __attribute__((ext_vector_type(4)));
                LAS unsigned char* vp_ = vb_ + vaddr + s2 * 16 * VROW;
                const v4i16_t a0 = __builtin_amdgcn_ds_read_tr16_b64_v4i16((LAS v4i16_t*)(vp_)), a1 = __builtin_amdgcn_ds_read_tr16_b64_v4i16((LAS v4i16_t*)(vp_ + 4 * VROW));
                const v4i16_t b0 = __builtin_amdgcn_ds_read_tr16_b64_v4i16((LAS v4i16_t*)(vp_ + 64)), b1 = __builtin_amdgcn_ds_read_tr16_b64_v4i16((LAS v4i16_t*)(vp_ + 4 * VROW + 64));
                const bf16x8 va = (bf16x8){a0[0], a0[1], a0[2], a0[3], a1[0], a1[1], a1[2], a1[3]};
                const bf16x8 vb = (bf16x8){b0[0], b0[1], b0[2], b0[3], b1[0], b1[1], b1[2], b1[3]};
                o0 = __builtin_amdgcn_mfma_f32_32x32x16_bf16(va, pp[s2], o0, 0, 0, 0);
                o1 = __builtin_amdgcn_mfma_f32_32x32x16_bf16(vb, pp[s2], o1, 0, 0, 0);
            }
        }
        if (more2) { *(LAS u32x4*)(lds + cur * KT + kdst0) = kr0; if (k2) *(LAS u32x4*)(lds + cur * KT + kdst1) = kr1; }
        if (more1) *(LAS u32x4*)(lds + (cur ^ 1) * VT + vdst) = vr;
        __syncthreads();
        p0 = n0; p1 = n1;
    }
    const float ltot = lrun + shx(lrun, 32, lane);
    const float inv = 1.f / ltot;
    bf16_t* orow = Op + (size_t)(wid * 32 + r32) * opitch;
#pragma unroll
    for (int g = 0; g < 4; ++g) {
        u32x2 w; w.x = pk2(o0[4 * g] * inv, o0[4 * g + 1] * inv); w.y = pk2(o0[4 * g + 2] * inv, o0[4 * g + 3] * inv);
        *(u32x2*)(orow + 8 * g + 4 * hi) = w;
        u32x2 w2; w2.x = pk2(o1[4 * g] * inv, o1[4 * g + 1] * inv); w2.y = pk2(o1[4 * g + 2] * inv, o1[4 * g + 3] * inv);
        *(u32x2*)(orow + 32 + 8 * g + 4 * hi) = w2;
    }
}

template <int NCH>
__device__ __forceinline__ void scan_unit(int wv, LAS unsigned char* lds, const bf16_t* A, bf16_t* HF, bf16_t* HB, const bf16_t* U, const bf16_t* GA, bf16_t* MIX, size_t row0, int T,
                                          const float* h0f, const float* h0b, float* outf, float* outb, int c0) {
    constexpr int NCK = 512 / NCH, BT = 16;
    LAS float* sPf = (LAS float*)lds; LAS float* sHf = sPf + 512; LAS float* sPb = sPf + 1024; LAS float* sHb = sPf + 1536;
    const int tid = otid(wv), cl = tid & (NCH - 1), c = c0 + cl, k = tid / NCH, L = T / NCK;
    const size_t rbase = row0 + (size_t)k * L;
    const size_t of_ = (((size_t)(c >> 3) * NTOK + rbase) << 3) + (c & 7), ob_ = of_ + (size_t)32 * NTOK * 8;
    const bf16_t* af = A + of_; const bf16_t* uf = U + of_;
    const bf16_t* ab = A + ob_; const bf16_t* ub = U + ob_;
    float hf = 0.f, Pf = 1.f, hb = 0.f, Pb = 1.f;
    for (int i = 0; i < L; i += BT) {
        float a[BT], u[BT], a2[BT], u2[BT];
#pragma unroll
        for (int j = 0; j < BT; ++j) { a[j] = 1.f - __builtin_bit_cast(float, (unsigned)af[(i + j) * 8] << 16); u[j] = __builtin_bit_cast(float, (unsigned)uf[(i + j) * 8] << 16); a2[j] = 1.f - __builtin_bit_cast(float, (unsigned)ab[(L - 1 - i - j) * 8] << 16); u2[j] = __builtin_bit_cast(float, (unsigned)ub[(L - 1 - i - j) * 8] << 16); }
#pragma unroll
        for (int j = 0; j < BT; ++j) { hf = a[j] * hf + u[j]; Pf *= a[j]; hb = a2[j] * hb + u2[j]; Pb *= a2[j]; }
    }
    sPf[tid] = Pf; sHf[tid] = hf; sPb[tid] = Pb; sHb[tid] = hb;
    __syncthreads();
    hf = h0f ? h0f[c] : 0.f; hb = h0b ? h0b[c] : 0.f;
    for (int kk = 0; kk < k; ++kk) hf = sPf[kk * NCH + cl] * hf + sHf[kk * NCH + cl];
    for (int kk = NCK - 1; kk > k; --kk) hb = sPb[kk * NCH + cl] * hb + sHb[kk * NCH + cl];
    bf16_t* hfp = HF + of_; bf16_t* hbp = HB + of_;
    for (int i = 0; i < L; i += BT) {
        float a[BT], u[BT], a2[BT], u2[BT];
#pragma unroll
        for (int j = 0; j < BT; ++j) { a[j] = 1.f - __builtin_bit_cast(float, (unsigned)af[(i + j) * 8] << 16); u[j] = __builtin_bit_cast(float, (unsigned)uf[(i + j) * 8] << 16); a2[j] = 1.f - __builtin_bit_cast(float, (unsigned)ab[(L - 1 - i - j) * 8] << 16); u2[j] = __builtin_bit_cast(float, (unsigned)ub[(L - 1 - i - j) * 8] << 16); }
#pragma unroll
        for (int j = 0; j < BT; ++j) { hf = a[j] * hf + u[j]; hfp[(i + j) * 8] = (bf16_t)f2bf(hf); hb = a2[j] * hb + u2[j]; hbp[(L - 1 - i - j) * 8] = (bf16_t)f2bf(hb); }
    }
    if (outf && k == NCK - 1) outf[c] = hf;
    if (outb && k == 0) outb[c] = hb;
    const bf16_t* gp = GA + of_; bf16_t* mp = MIX + rbase * 1024 + c;
    for (int i = 0; i < L; i += BT) {
        float x[BT], y[BT], g[BT];
#pragma unroll
        for (int j = 0; j < BT; ++j) { x[j] = __builtin_bit_cast(float, (unsigned)hfp[(i + j) * 8] << 16); y[j] = __builtin_bit_cast(float, (unsigned)hbp[(i + j) * 8] << 16); g[j] = __builtin_bit_cast(float, (unsigned)gp[(i + j) * 8] << 16); }
#pragma unroll
        for (int j = 0; j < BT; ++j) mp[(size_t)(i + j) * 1024] = (bf16_t)f2bf(g[j] * (x[j] + y[j]));
    }
    __syncthreads();
}

__device__ __forceinline__ void transpose_item(const float* W, int K, int N, bf16_t* WT, LAS float* scr, int item, int lane, int mode, float f8scale = 0.f) {
    const int nblk = N / 32, kb = item / nblk, nb = item % nblk, k0 = 64 * kb, n0 = 32 * nb;
#pragma unroll 8
    for (int i = 0; i < 32; ++i) { const int kk = 2 * i + (lane >> 5); scr[kk * 33 + (lane & 31)] = W[(size_t)(k0 + kk) * N + n0 + (lane & 31)]; }
    asm volatile("s_waitcnt lgkmcnt(0)" ::: "memory");
    const int c = lane & 7;
#pragma unroll
    for (int j = 0; j < 4; ++j) {
        const int nl = (lane >> 3) + 8 * j; const LAS float* s = scr + (8 * c) * 33 + nl;
        u32x4 o; o.x = pk2(s[0 * 33], s[1 * 33]); o.y = pk2(s[2 * 33], s[3 * 33]); o.z = pk2(s[4 * 33], s[5 * 33]); o.w = pk2(s[6 * 33], s[7 * 33]);
        const int n = n0 + nl;
        const int dr = (mode == 0) ? n : ((n >> 7) * 256 + (mode == 2 ? 128 : 0) + (n & 127));
        if (f8scale != 0.f) { u32x2 o8; o8.x = pk4_fp8(s[0 * 33] * f8scale, s[1 * 33] * f8scale, s[2 * 33] * f8scale, s[3 * 33] * f8scale); o8.y = pk4_fp8(s[4 * 33] * f8scale, s[5 * 33] * f8scale, s[6 * 33] * f8scale, s[7 * 33] * f8scale);
            *(u32x2*)((unsigned char*)WT + (size_t)dr * K + k0 + 8 * c) = o8; }
        else *(u32x4*)(WT + (size_t)dr * K + k0 + 8 * c) = o;
    }
    asm volatile("s_waitcnt lgkmcnt(0)" ::: "memory");
}

__device__ __forceinline__ void weight_prep(int wv, const Params& p, unsigned char* ws, int l, LAS unsigned char* lds) {
    const int tid = otid(wv), lane = tid & 63, wave = tid >> 6;
    LAS float* scr = (LAS float*)(lds + wave * 8704);
    const int gw = obx() * 8 + wave, NGW = ogd() * 8;
    bf16_t* Wgu = (bf16_t*)(ws + WS_WGU); bf16_t* Wd = (bf16_t*)(ws + WS_WD); bf16_t* Win = (bf16_t*)(ws + WS_WIN); bf16_t* Wout = (bf16_t*)(ws + WS_WOUT);
    constexpr int I_G = 16 * 88, I_D = 44 * 32, I_IN = 16 * 51, I_OUT = 16 * 32;
    constexpr int NIT = 2 * (2 * I_G + I_D) + I_IN + I_OUT;
    for (int it = gw; it < NIT; it += NGW) {
        int r = it;
        if (r < 2 * (2 * I_G + I_D)) {
            const int j = r / (2 * I_G + I_D); r -= j * (2 * I_G + I_D);
            const size_t wo = (size_t)(l * 2 + j) * DM * DFF;
            if (r < I_G) { transpose_item(INP(p, 13) + wo, DM, DFF, (bf16_t*)((unsigned char*)Wgu + (size_t)j * 5632 * 1024), scr, r, lane, 1, WGU_SCALE); continue; } r -= I_G;
            if (r < I_G) { transpose_item(INP(p, 14) + wo, DM, DFF, (bf16_t*)((unsigned char*)Wgu + (size_t)j * 5632 * 1024), scr, r, lane, 2, WGU_SCALE); continue; } r -= I_G;
            transpose_item(INP(p, 15) + wo, DFF, DM, (bf16_t*)((unsigned char*)Wd + (size_t)j * 1024 * 2816), scr, r, lane, 0, WD_SCALE); continue;
        }
        r -= 2 * (2 * I_G + I_D);
        if (r < I_IN) { transpose_item(INP(p, 16) + (size_t)l * DM * ZP, DM, ZP, Win, scr, r, lane, 0); continue; } r -= I_IN;
        transpose_item(INP(p, 17) + (size_t)l * DM * DM, DM, DM, Wout, scr, r, lane, 0);
    }
    const size_t gt = (size_t)obx() * 512 + tid, NT = (size_t)ogd() * 512;
    bf16_t* Wlru = (bf16_t*)(ws + WS_WLRU); bf16_t* Wuq = (bf16_t*)(ws + WS_WUQ); bf16_t* Wukv = (bf16_t*)(ws + WS_WUKV);
    for (size_t i = gt; i < (size_t)160 * 1024; i += NT) Win[(size_t)ZP * 1024 + i] = 0;
    for (size_t i = gt; i < (size_t)1024 * 256; i += NT) {
        const int n = (int)(i >> 8), k = (int)(i & 255);
        const int pn = n >> 8, bj = (n >> 7) & 1, jl = n & 127, combo = pn * 128 + jl, dir = combo >> 8, ch = combo & 255, blk = ch >> 6, jj = ch & 63;
        float v = 0.f;
        if ((k >> 6) == blk) v = (bj ? INP(p, 22) : INP(p, 20))[((((size_t)l * 2 + dir) * 4 + blk) * 64 + (k & 63)) * 64 + jj];
        Wlru[i] = (bf16_t)f2bf(v);
    }
    for (size_t i = gt; i < (size_t)512 * 256; i += NT) {
        const int n = (int)(i >> 8), k = (int)(i & 255);
        float v = 0.f; if (n < 384 && k < 192) v = INP(p, 28)[((size_t)l * 192 + k) * 384 + n];
        Wuq[i] = (bf16_t)f2bf(v);
        float w = 0.f; if (k < 128) w = (n < 256) ? INP(p, 30)[((size_t)l * 128 + k) * 256 + n] : INP(p, 31)[((size_t)l * 128 + k) * 256 + (n - 256)];
        Wukv[i] = (bf16_t)f2bf(w);
    }
}

__device__ __forceinline__ void sincos_d(double r, float& c, float& s) {
    const double r2 = r * r; double ts = r, tc = 1.0, ss = r, cc = 1.0;
#pragma unroll 1
    for (int n = 1; n <= 14; ++n) { tc = -tc * r2 / (double)((2 * n - 1) * (2 * n)); ts = -ts * r2 / (double)((2 * n) * (2 * n + 1)); cc += tc; ss += ts; }
    c = (float)cc; s = (float)ss;
}

__device__ __forceinline__ void phase_prologue0(int wv, const Params& p, unsigned char* ws, LAS unsigned char* lds) {
    const int tid = otid(wv), lane = tid & 63, wave = tid >> 6;
    LAS float* sc = (LAS float*)lds;
    LAS float* red = sc + 5120;
    float* mod = (float*)(ws + WS_MOD);
    for (int idx = tid; idx < 5120; idx += 512) { const int g = idx >> 10, k = idx & 1023; const float v = (g == 0) ? INP(p, 8)[k] : INP(p, 7)[(g - 1) * 1024 + k]; sc[idx] = siluf(v); }
    __syncthreads();
    for (int item = obx(); item < 576; item += ogd()) {
        const int l = item / 144, cb = item % 144, n = cb * 64 + lane;
        const float* wp = INP(p, 9) + ((size_t)l * 1024 + wave * 128) * 9216 + n;
        float a0 = 0.f, a1 = 0.f, a2 = 0.f, a3 = 0.f, a4 = 0.f;
        for (int k = 0; k < 128; k += 8) {
            float w[8];
#pragma unroll
            for (int j = 0; j < 8; ++j) w[j] = wp[(size_t)(k + j) * 9216];
#pragma unroll
            for (int j = 0; j < 8; ++j) { const int kk = wave * 128 + k + j; a0 += sc[kk] * w[j]; a1 += sc[1024 + kk] * w[j]; a2 += sc[2048 + kk] * w[j]; a3 += sc[3072 + kk] * w[j]; a4 += sc[4096 + kk] * w[j]; }
        }
        red[(wave * 5 + 0) * 64 + lane] = a0; red[(wave * 5 + 1) * 64 + lane] = a1; red[(wave * 5 + 2) * 64 + lane] = a2; red[(wave * 5 + 3) * 64 + lane] = a3; red[(wave * 5 + 4) * 64 + lane] = a4;
        __syncthreads();
        if (tid < 320) { const int g = tid >> 6, ln = tid & 63; float s = INP(p, 10)[(size_t)l * 9216 + cb * 64 + ln];
#pragma unroll
            for (int w = 0; w < 8; ++w) s += red[(w * 5 + g) * 64 + ln];
            mod[((size_t)l * 5 + g) * 9216 + cb * 64 + ln] = s; }
        __syncthreads();
    }
    if (obx() == ogd() - 1) {
        f32x2* r64 = (f32x2*)(ws + WS_R64); f32x2* r32 = (f32x2*)(ws + WS_R32);
        { float* lgc = (float*)(ws + WS_LNG); const float* g0 = INP(p, 11); const float* b0 = INP(p, 12);
          for (int i = tid; i < 12 * 1024; i += 512) { lgc[i] = g0[i]; lgc[12 * 1024 + i] = b0[i]; } }
        float* spt = (float*)(ws + WS_SPT);
#pragma clang loop unroll(disable) vectorize(disable)
        for (int i = tid; i < 4 * 512; i += 512) {
            const float x = __expf(-INP(p, 24)[i]);
            const float sp_ = (x < 0.03125f) ? x * (1.f - x * (0.5f - x * ((1.f / 3.f) - x * (0.25f - 0.2f * x)))) : __logf(1.f + x);
            spt[i] = -8.f * sp_;
        }
        for (int i = tid; i < 64 * 16 + 64 * 8; i += 512) {
            int pos, f, nf; if (i < 1024) { pos = i >> 4; f = i & 15; nf = 16; } else { const int j = i - 1024; pos = j >> 3; f = j & 7; nf = 8; }
            const float inv = exp2f(-(float)f / (float)nf * 13.287712379549449f);
            const float ang = (float)pos * inv;
            const double kq = rint((double)ang * 0.15915494309189535); const double r = (double)ang - kq * 6.283185307179586476925;
            float c, s; sincos_d(r, c, s);
            if (i < 1024) r64[i] = (f32x2){c, s}; else r32[i - 1024] = (f32x2){c, s};
        }
    }
    __syncthreads();
    weight_prep(wv, p, ws, 0, lds);
}

__device__ __forceinline__ void ln_phase(int wv, const Params& p, unsigned char* ws, float* out, int l, int which, int lnext, int nextmod  , bool first_copy) {
    const int tid = otid(wv), lane = tid & 63, wave = tid >> 6;
    const int gw = obx() * 8 + wave, NGW = ogd() * 8;
    float* X = out; bf16_t* Ub = (bf16_t*)(ws + WS_U); const float* mod = (const float*)(ws + WS_MOD);
    float* stp = (float*)(ws + WS_ST);
    const float* lg = INP(p, 11) + ((size_t)l * 3 + which) * 1024; const float* lb = INP(p, 12) + ((size_t)l * 3 + which) * 1024;
    for (int row = gw; row < NTOK; row += NGW) {
        const float* src = first_copy ? (row < NP ? INP(p, 0) + (size_t)row * DM : INP(p, 1) + (size_t)(row - NP) * DM) : X + (size_t)row * DM;
        f32x4 v[4];
#pragma unroll
        for (int j = 0; j < 4; ++j) v[j] = *(const f32x4*)(src + 4 * lane + 256 * j);
        if (first_copy) { if (lane == 0) *(f32x2*)(stp + 2 * (size_t)row) = (f32x2){0.f, 1.f}; }
        if (!first_copy) {
            float s = 0.f;
#pragma unroll
            for (int j = 0; j < 4; ++j) s += (v[j].x + v[j].y) + (v[j].z + v[j].w);
            const float mean = wave_sum(s, lane) * (1.f / DM); float s2 = 0.f;
#pragma unroll
            for (int j = 0; j < 4; ++j) { v[j] = v[j] - mean; s2 += (v[j].x * v[j].x + v[j].y * v[j].y) + (v[j].z * v[j].z + v[j].w * v[j].w); }
            const float rstd = rsqrtf(wave_sum(s2, lane) * (1.f / DM) + 1e-6f);
            if (nextmod >= 0 && lane == 0) *(f32x2*)(stp + 2 * (size_t)row) = (f32x2){mean, rstd};
#pragma unroll
            for (int j = 0; j < 4; ++j) { const f32x4 g = *(const f32x4*)(lg + 4 * lane + 256 * j), b = *(const f32x4*)(lb + 4 * lane + 256 * j); v[j] = v[j] * rstd * g + b; }
        }
        if (first_copy || nextmod < 0) {
#pragma unroll
            for (int j = 0; j < 4; ++j) *(f32x4*)(X + (size_t)row * DM + 4 * lane + 256 * j) = v[j];
        }
        if (nextmod >= 0) {
            const int grp = row < NP ? 0 : 1 + ((row - NP) >> 12);
            const float* mp = mod + ((size_t)lnext * 5 + grp) * 9216 + nextmod * 3 * 1024;
#pragma unroll
            for (int j = 0; j < 4; ++j) {
                const f32x4 sh = *(const f32x4*)(mp + 4 * lane + 256 * j), scv = *(const f32x4*)(mp + 1024 + 4 * lane + 256 * j);
                const f32x4 u = v[j] * (scv + 1.f) + sh;
                if (nextmod == 1) { u32x2 w; w.x = pk2(u.x, u.y); w.y = pk2(u.z, u.w); *(u32x2*)(Ub + (size_t)row * DM + 4 * lane + 256 * j) = w; }
                else *(unsigned*)((unsigned char*)Ub + (size_t)row * DM + 4 * lane + 256 * j) = pk4_fp8(u.x, u.y, u.z, u.w);
            }
        }
    }
}

struct PostRow { u32x2 cv0, cv1, cv2, cv3, gt, cq; u32x4 q, pz; f32x4 pa, pb; };

#define POST_DECODE \
        const bool cache = item >= NTOK; \
        int b, t, T; bool samp; size_t rowc; const int row = item; \
        if (cache) { const int r2 = item - NTOK; b = r2 >> 8; t = r2 & 255; T = 256; samp = true; rowc = (size_t)NP + (size_t)b * SKV + t; } \
        else if (row < NP) { b = row >> 8; t = row & 255; T = 256; samp = false; rowc = row; } \
        else { const int r2 = row - NP; b = r2 >> 12; t = r2 & 4095; T = 4096; samp = true; rowc = (size_t)NP + (size_t)b * SKV + 256 + t; } \
        const int grow = t >> 6, gcol = t & 63; \
        const bf16_t* z = Z + (size_t)row * ZP; (void)grow; (void)gcol; (void)rowc; (void)samp; (void)T;
__device__ __forceinline__ void post_load(const Params& p, unsigned char* ws, int l, int item, int lane, PostRow& R) {
    const bf16_t* Z = (const bf16_t*)(ws + WS_H);
    {
        POST_DECODE
        const u32x2 z2 = {0u, 0u};
        R.cv0 = z2; R.cv1 = z2; R.cv2 = z2; R.cv3 = z2; R.gt = z2; R.cq = z2; R.q = (u32x4){0u, 0u, 0u, 0u}; R.pz = (u32x4){0u, 0u, 0u, 0u};
        R.pa = (f32x4){0.f, 0.f, 0.f, 0.f}; R.pb = (f32x4){0.f, 0.f, 0.f, 0.f};
        if (!cache) {
            if (t - 1 >= 0) R.cv0 = *(const u32x2*)(z - ZP + 4 * lane);
            R.cv1 = *(const u32x2*)(z + 4 * lane);
            if (t + 1 < T) R.cv2 = *(const u32x2*)(z + ZP + 4 * lane);
            if (t + 2 < T) R.cv3 = *(const u32x2*)(z + 2 * ZP + 4 * lane);
            R.gt = *(const u32x2*)(z + 256 + 4 * lane);
            R.q = *(const u32x4*)(z + 512 + 8 * lane);
            if (lane < 48) R.cq = *(const u32x2*)(z + 1280 + 4 * lane);
            if (lane < 52) R.pz = *(const u32x4*)(z + (lane < 32 ? 1024 + 8 * lane : lane < 48 ? 1472 + 8 * (lane - 32) : 1600 + 8 * (lane - 48)));
        } else if (lane < 52) {
            const size_t cr = ((size_t)b * 4 + l) * 256 + t;
            const float* src = lane < 16 ? INP(p, 2) + cr * 128 + 8 * lane : lane < 32 ? INP(p, 3) + cr * 128 + 8 * (lane - 16) : lane < 48 ? INP(p, 4) + cr * 128 + 8 * (lane - 32) : INP(p, 5) + cr * 32 + 8 * (lane - 48);
            R.pa = *(const f32x4*)src; R.pb = *(const f32x4*)(src + 4);
        }
    }
}
__device__ __forceinline__ void post_process(const Params& p, unsigned char* ws, float* out, int l, int item, int lane, const PostRow& R, const LAS float* tb) {
    const bf16_t* Z = (const bf16_t*)(ws + WS_H);
    float* XCf = (float*)(ws + WS_XCF); bf16_t* XCb = (bf16_t*)(ws + WS_XCB); bf16_t* GA = (bf16_t*)(ws + WS_GA);
    bf16_t* Qg = (bf16_t*)(ws + WS_QG); bf16_t* Kg = (bf16_t*)(ws + WS_KG); bf16_t* Vtg = (bf16_t*)(ws + WS_VTG);
    bf16_t* CQN = (bf16_t*)(ws + WS_CQN); bf16_t* CKV = (bf16_t*)(ws + WS_CKV); bf16_t* Kc = (bf16_t*)(ws + WS_KC);
    const LAS float* convw = tb; const LAS float* convb = tb + 1024; const LAS float* qn = tb + 1280; const LAS float* kn = tb + 1344; const LAS float* mqn = tb + 1408; const LAS float* mkn = tb + 1600;
    const LAS f32x2* r64 = (const LAS f32x2*)(tb + 1728); const LAS f32x2* r32t = (const LAS f32x2*)(tb + 3776);
    {
        POST_DECODE
        const f32x4 cvx[4] = {bf4(R.cv0), bf4(R.cv1), bf4(R.cv2), bf4(R.cv3)}; const f32x4 gt = bf4(R.gt), qa = bf4((u32x2){R.q.x, R.q.y}), qbv = bf4((u32x2){R.q.z, R.q.w}), cqv = bf4(R.cq);
        const f32x4 pa = cache ? R.pa : bf4((u32x2){R.pz.x, R.pz.y}), pb = cache ? R.pb : bf4((u32x2){R.pz.z, R.pz.w});
        if (!cache) {
            { const int c = 4 * lane; f32x4 acc = *(const LAS f32x4*)(convb + c);
#pragma unroll
              for (int j = 0; j < 4; ++j) { const f32x4 w = *(const LAS f32x4*)(convw + j * 256 + c); acc = acc + w * cvx[j]; }
              u32x2 w; w.x = pk2(acc.x, acc.y); w.y = pk2(acc.z, acc.w); *(u32x2*)(XCb + (size_t)row * 256 + c) = w; }
            { f32x4 g = gt; g.x = gelu_tanh(g.x); g.y = gelu_tanh(g.y); g.z = gelu_tanh(g.z); g.w = gelu_tanh(g.w); u32x2 gw; gw.x = pk2(g.x, g.y); gw.y = pk2(g.z, g.w); *(u32x2*)(GA + ((((size_t)(lane >> 1)) * NTOK + row) << 3) + 4 * (lane & 1)) = gw; }
            { float y[8] = {qa.x, qa.y, qa.z, qa.w, qbv.x, qbv.y, qbv.z, qbv.w};
              float ss = 0.f;
#pragma unroll
              for (int i = 0; i < 8; ++i) ss += y[i] * y[i];
              ss += shx(ss, 1, lane); ss += shx(ss, 2, lane); ss += shx(ss, 4, lane);
              const float rstd = rsqrtf(ss * (1.f / 64.f) + 1e-6f);
#pragma unroll
              for (int i = 0; i < 8; ++i) y[i] = y[i] * rstd * qn[(lane & 7) * 8 + i];
              const int pos = ((lane & 3) < 2) ? grow : gcol; const LAS f32x2* cs = r64 + pos * 16 + (lane & 1) * 8;
              const float sg = (lane & 4) ? 1.f : -1.f;
#pragma unroll
              for (int i = 0; i < 8; ++i) { const float pa_ = shx(y[i], 4, lane); if (samp) { const f32x2 c = cs[i]; y[i] = y[i] * c.x + sg * pa_ * c.y; } }
              u32x4 w; w.x = pk2(y[0] * C2G, y[1] * C2G); w.y = pk2(y[2] * C2G, y[3] * C2G); w.z = pk2(y[4] * C2G, y[5] * C2G); w.w = pk2(y[6] * C2G, y[7] * C2G);
              *(u32x4*)(Qg + (size_t)row * 512 + 8 * lane) = w; }
            { f32x4 v = cqv;
              const float ss = wave_sum(v.x * v.x + v.y * v.y + v.z * v.z + v.w * v.w, lane);
              const float rstd = rsqrtf(ss * (1.f / 192.f) + 1e-6f);
              u32x2 w = (u32x2){0u, 0u};
              if (lane < 48) { const f32x4 g = *(const LAS f32x4*)(mqn + 4 * lane); v = v * rstd * g; w.x = pk2(v.x, v.y); w.y = pk2(v.z, v.w); }
              *(u32x2*)(CQN + (size_t)row * 256 + 4 * lane) = w; }
        }
        {
            float y[8] = {pa.x, pa.y, pa.z, pa.w, pb.x, pb.y, pb.z, pb.w};
            float ss = 0.f;
#pragma unroll
            for (int i = 0; i < 8; ++i) ss += y[i] * y[i];
            ss += shx(ss, 1, lane); ss += shx(ss, 2, lane); ss += shx(ss, 4, lane);
            const float ss16 = ss + shx(ss, 8, lane);
            if (!cache) {
                if (lane < 16) { const float rstd = rsqrtf(ss * (1.f / 64.f) + 1e-6f);
#pragma unroll
                    for (int i = 0; i < 8; ++i) y[i] = y[i] * rstd * kn[(lane & 7) * 8 + i]; }
                else if (lane >= 32 && lane < 48) { const float rstd = rsqrtf(ss16 * (1.f / 128.f) + 1e-6f);
#pragma unroll
                    for (int i = 0; i < 8; ++i) y[i] = y[i] * rstd * mkn[(lane - 32) * 8 + i]; }
            }
            if (!cache && !samp && lane < 52) {
                const size_t cr = ((size_t)b * 4 + l) * 256 + t;
                float* op = lane < 16 ? out + O_K + cr * 128 + 8 * lane : lane < 32 ? out + O_V + cr * 128 + 8 * (lane - 16) : lane < 48 ? out + O_CKV + cr * 128 + 8 * (lane - 32) : out + O_KR + cr * 32 + 8 * (lane - 48);
                *(f32x4*)op = (f32x4){y[0], y[1], y[2], y[3]}; *(f32x4*)(op + 4) = (f32x4){y[4], y[5], y[6], y[7]};
            }
            {
                const bool dorope = samp && !cache;
                const int posk = ((lane & 3) < 2) ? grow : gcol; const LAS f32x2* csk = r64 + posk * 16 + (lane & 1) * 8;
                const int posr = (lane & 1) ? gcol : grow; const LAS f32x2* csr = r32t + posr * 8;
                const float sgk = (lane & 4) ? 1.f : -1.f, sgr = (lane & 2) ? 1.f : -1.f;
#pragma unroll
                for (int i = 0; i < 8; ++i) {
                    const float p4 = shx(y[i], 4, lane), p2 = shx(y[i], 2, lane);
                    if (dorope) {
                        if (lane < 16) { const f32x2 c = csk[i]; y[i] = y[i] * c.x + sgk * p4 * c.y; }
                        else if (lane >= 48 && lane < 52) { const f32x2 c = csr[i]; y[i] = y[i] * c.x + sgr * p2 * c.y; }
                    }
                }
            }
            u32x4 w; w.x = pk2(y[0], y[1]); w.y = pk2(y[2], y[3]); w.z = pk2(y[4], y[5]); w.w = pk2(y[6], y[7]);
            if (lane < 16) {
                bf16_t* kp = samp ? Kg + KG_S + ((size_t)b * SKV + (cache ? t : 256 + t)) * 128 : Kg + ((size_t)b * 256 + t) * 128;
                *(u32x4*)(kp + 8 * lane) = w;
            } else if (lane < 32) {
                bf16_t* vp = samp ? Vtg + KG_S + ((size_t)b * SKV + (cache ? t : 256 + t)) * 128 : Vtg + ((size_t)b * 256 + t) * 128;
                *(u32x4*)(vp + 8 * (lane - 16)) = w;
            } else if (lane < 48) {
                *(u32x4*)(CKV + rowc * 256 + 8 * (lane - 32)) = w;
            } else if (lane < 52) {
                bf16_t* kp = Kc + rowc * 384 + 64 + 8 * (lane - 48);
                *(u32x4*)kp = w; *(u32x4*)(kp + 96) = w; *(u32x4*)(kp + 192) = w; *(u32x4*)(kp + 288) = w;
            }
            if (lane >= 48) { const unsigned zz = __builtin_bit_cast(unsigned, ozero()); *(u32x4*)(CKV + rowc * 256 + 128 + 8 * (lane - 48)) = (u32x4){zz, zz, zz, zz}; }
        }
    }
}
__device__ __forceinline__ void post_phase(int wv, const Params& p, unsigned char* ws, float* out, int l, LAS unsigned char* lds) {
    const int tid = otid(wv), lane = tid & 63, wave = tid >> 6;
    LAS float* tb = (LAS float*)lds;
    {
        const float* cw = INP(p, 18) + (size_t)l * 1024; const float* cb = INP(p, 19) + (size_t)l * 256;
        const float* qn_ = INP(p, 25) + l * 64; const float* kn_ = INP(p, 26) + l * 64; const float* mqn_ = INP(p, 27) + l * 192; const float* mkn_ = INP(p, 29) + l * 128;
        const float* r64_ = (const float*)(ws + WS_R64); const float* r32_ = (const float*)(ws + WS_R32);
        for (int i = tid; i < 4800; i += 512) {
            float v;
            if (i < 1024) v = cw[i]; else if (i < 1280) v = cb[i - 1024]; else if (i < 1344) v = qn_[i - 1280]; else if (i < 1408) v = kn_[i - 1344];
            else if (i < 1600) v = mqn_[i - 1408]; else if (i < 1728) v = mkn_[i - 1600]; else if (i < 3776) v = r64_[i - 1728]; else v = r32_[i - 3776];
            tb[i] = v;
        }
        __syncthreads();
    }
    constexpr int NITEM = NTOK + 1024;
    const int G = ogd(), per = (NITEM + G - 1) / G, lo = obx() * per, hi_ = (lo + per < NITEM) ? lo + per : NITEM;
    int item = lo + wave;
    PostRow cur = {}, nxt = {};
    if (item < hi_) post_load(p, ws, l, item, lane, cur);
    while (item < hi_) {
        const int nitem = item + 8;
        if (nitem < hi_) post_load(p, ws, l, nitem, lane, nxt);
        post_process(p, ws, out, l, item, lane, cur, tb);
        cur = nxt; item = nitem;
    }
}

__device__ __forceinline__ void mixer_phase(int wv, const Params& p, unsigned char* ws, float* out, int l, LAS unsigned char* lds, int mask) {
    const bf16_t* Qg = (const bf16_t*)(ws + WS_QG); const bf16_t* Kg = (const bf16_t*)(ws + WS_KG); const bf16_t* Vtg = (const bf16_t*)(ws + WS_VTG);
    const bf16_t* Qc = (const bf16_t*)(ws + WS_QC); const bf16_t* Kc = (const bf16_t*)(ws + WS_KC); const bf16_t* Vtc = (const bf16_t*)(ws + WS_VTC);
    bf16_t* MIX = (bf16_t*)(ws + WS_U);
    const bf16_t* A = (const bf16_t*)(ws + WS_A); bf16_t* HF = (bf16_t*)(ws + WS_HF); bf16_t* HB = (bf16_t*)(ws + WS_HB); const bf16_t* U = (const bf16_t*)(ws + WS_UU); const bf16_t* Z = (const bf16_t*)(ws + WS_GA);
    const int G = ogd(), bx = obx();
    if (mask & 1) for (int it = 0; it < 2; ++it) {
        if (bx < 128 && it) break;
        const int u = (bx < 128) ? bx : bx + it * 128;
        if (u < 128) { const int b = u >> 5, cg8 = u & 31; const float* st = INP(p, 6) + ((size_t)b * 4 + l) * 512;
            scan_unit<8>(wv, lds, A, HF, HB, U, Z, MIX, (size_t)NP + (size_t)b * 4096, 4096, st, st + 256, nullptr, nullptr, cg8 * 8); }
        else { const int v = u - 128, b = v >> 3, cg8 = v & 7; float* so = out + O_LRU + ((size_t)b * 4 + l) * 512;
            scan_unit<32>(wv, lds, A, HF, HB, U, Z, MIX, (size_t)b * 256, 256, nullptr, nullptr, so, so + 256, cg8 * 32); }
    }
    if (mask & 2) for (int i = 0; i < 2; ++i) {
        const int xcd = bx & 7, idx = (bx >> 3) * 2 + i;
        const int qb = idx & 15, h = (xcd & 1) * 4 + (idx >> 4), b = xcd >> 1, kvh = h >> 2; const size_t row0 = (size_t)NP + (size_t)b * 4096 + qb * 256;
        attn_unit<64>(wv, lds, Qg + row0 * 512 + h * 64, 512, Kg + KG_S + (size_t)b * SKV * 128 + kvh * 64, 128, Vtg + KG_S + (size_t)b * SKV * 128 + kvh * 64, 128, SKV, MIX + row0 * 1024 + 256 + h * 64, 1024);
    }
    if (mask & 4) {
        const int xcd = bx & 7, slot = bx >> 3;
        const int qb = slot & 15, h = (xcd & 1) * 2 + (slot >> 4), b = xcd >> 1; const size_t row0 = (size_t)NP + (size_t)b * 4096 + qb * 256;
        attn_unit<96>(wv, lds, Qc + row0 * 384 + h * 96, 384, Kc + ((size_t)NP + (size_t)b * SKV) * 384 + h * 96, 384, Vtc + ((size_t)NP + (size_t)b * SKV) * 256 + h * 64, 256, SKV, MIX + row0 * 1024 + 768 + h * 64, 1024);
    }
    if (mask & 8) for (int u = bx - 128; u < 256; u += 128) {
        if (u < 0) break;
        const int h = u & 7, b = u >> 3, kvh = h >> 2; const size_t row0 = (size_t)b * 256;
        attn_unit<64>(wv, lds, Qg + row0 * 512 + h * 64, 512, Kg + (size_t)b * 256 * 128 + kvh * 64, 128, Vtg + (size_t)b * 256 * 128 + kvh * 64, 128, 256, MIX + row0 * 1024 + 256 + h * 64, 1024);
    }
    if (mask & 16) for (int u = (bx + 128) & 255; u < 128; u += G) {
        const int h = u & 3, b = u >> 2; const size_t row0 = (size_t)b * 256;
        attn_unit<96>(wv, lds, Qc + row0 * 384 + h * 96, 384, Kc + row0 * 384 + h * 96, 384, Vtc + row0 * 256 + h * 64, 256, 256, MIX + row0 * 1024 + 768 + h * 64, 1024);
    }
}

#define XB_TMO      128
#define XB_XCNT(j)  (256  + 64 * (j))
#define XB_XSUB(j)  (1280 + 64 * (j))
#define XB_XGEN(j)  (2304 + 64 * (j))
#define XB_TOP      3328
#define XB_TOPGEN   3392
#define XB_SPIN_CAP (1u << 18)
__device__ __forceinline__ unsigned xb_ld(unsigned* p)              { return __hip_atomic_load(p, __ATOMIC_RELAXED, __HIP_MEMORY_SCOPE_AGENT); }
__device__ __forceinline__ unsigned xb_add(unsigned* p, unsigned v) { return __hip_atomic_fetch_add(p, v, __ATOMIC_RELAXED, __HIP_MEMORY_SCOPE_AGENT); }
__device__ __forceinline__ unsigned xb_xcc_id() { return (unsigned)__builtin_amdgcn_s_getreg((3 << 11) | 20) & 0xFu; }
#define XB_SPIN(cond, bar) do { unsigned _sp = 0; while (cond) { __builtin_amdgcn_s_sleep(1); \
    if ((++_sp & 255u) == 0u) { if (xb_ld(&(bar)[XB_TMO])) break; if (_sp > XB_SPIN_CAP) { atomicAdd(&(bar)[XB_TMO], 1u); break; } } } } while (0)
__device__ __forceinline__ void xcd_barrier_complete(unsigned* bar, unsigned x, unsigned& nloc, unsigned& nx) {
    const unsigned G = gridDim.x;
    unsigned sum, cnt, mine, sp = 0u;
    for (;;) {
        sum = 0u; cnt = 0u; mine = 0u;
#pragma unroll
        for (unsigned j = 0; j < 16; ++j) { const unsigned c = xb_ld(&bar[XB_XCNT(j)]); sum += c; cnt += (c > 0u) ? 1u : 0u; mine = (j == x) ? c : mine; }
        if (sum == G) break;
        __builtin_amdgcn_s_sleep(1);
        if ((++sp & 255u) == 0u) { if (xb_ld(&bar[XB_TMO])) break; if (sp > XB_SPIN_CAP) { atomicAdd(&bar[XB_TMO], 1u); break; } }
    }
    nloc = mine > 0u ? mine : 1u; nx = cnt > 0u ? cnt : 1u;
}
__device__ __forceinline__ void xcd_barrier(int wv, unsigned* bar, volatile LAS unsigned* st) {
    asm volatile("s_waitcnt vmcnt(0)" ::: "memory");
    __syncthreads();
    if (otid(wv) == 0) {
        const unsigned x = xb_xcc_id();
        __builtin_amdgcn_s_waitcnt(0);
        unsigned nloc = st[0], nx = st[1];
        if (nloc == 0u) { xcd_barrier_complete(bar, x, nloc, nx); st[0] = nloc; st[1] = nx; }
        const unsigned old = xb_add(&bar[XB_XSUB(x)], 1u);
        const unsigned gen = old / nloc;
        if (old + 1u == (gen + 1u) * nloc) {
            __builtin_amdgcn_fence(__ATOMIC_RELEASE, "agent");
            asm volatile("s_waitcnt vmcnt(0)" ::: "memory");
            const unsigned og = xb_add(&bar[XB_TOP], 1u);
            const unsigned tg = og / nx;
            if (og + 1u == (tg + 1u) * nx) xb_add(&bar[XB_TOPGEN], 1u);
            else XB_SPIN(xb_ld(&bar[XB_TOPGEN]) == tg, bar);
            __builtin_amdgcn_fence(__ATOMIC_ACQUIRE, "agent");
            xb_add(&bar[XB_XGEN(x)], 1u);
            asm volatile("s_waitcnt vmcnt(0)" ::: "memory");
        } else {
            XB_SPIN(xb_ld(&bar[XB_XGEN(x)]) == gen, bar);
            __builtin_amdgcn_fence(__ATOMIC_ACQUIRE, "agent");
            asm volatile("s_waitcnt vmcnt(0)" ::: "memory");
        }
    }
    __syncthreads();
}

constexpr int N_PHASES = 2 + 12 * NLAYER;
__global__ void __launch_bounds__(512, 2) fwd_megakernel(Params p) {
    extern __shared__ __attribute__((aligned(16))) unsigned char lds_raw[];
    LAS unsigned char* lds = (LAS unsigned char*)lds_raw;
    cg::grid_group grid = cg::this_grid();
    const int wv = __builtin_amdgcn_readfirstlane((int)(threadIdx.x >> 6));
    volatile LAS unsigned* bst = (volatile LAS unsigned*)(lds + 131072 + 512);
    if (threadIdx.x == 0) { bst[0] = 0u; bst[1] = 0u; (void)xb_add((unsigned*)(p.ws + WS_BAR) + XB_XCNT(xb_xcc_id()), 1u); }
    __syncthreads();
    for (int ph = p.ph_lo; ph < p.ph_hi; ++ph) {
        __attribute__((address_space(1))) unsigned char* wsg = (__attribute__((address_space(1))) unsigned char*)p.ws;
        __attribute__((address_space(1))) float* outg = (__attribute__((address_space(1))) float*)p.out;
        asm volatile("" : "+s"(wsg), "+s"(outg));
        unsigned char* ws = (unsigned char*)wsg; float* out = (float*)outg;
        const float* mod = (const float*)(ws + WS_MOD);
        float* X = out;
        if (ph == 0) { phase_prologue0(wv, p, ws, lds); if (DUP_K == 101) { __syncthreads(); phase_prologue0(wv, p, ws, lds); } }
        else if (ph == 1) { ln_phase(wv, p, ws, out, 0, 0, 0, 0, true); if (DUP_K == 100) { ln_phase(wv, p, ws, out, 0, 0, 0, 0, true); ln_phase(wv, p, ws, out, 0, 0, 0, 0, true); ln_phase(wv, p, ws, out, 0, 0, 0, 0, true); ln_phase(wv, p, ws, out, 0, 0, 0, 0, true); } }
        else {
            const int l = (ph - 2) / 12, k = (ph - 2) % 12;
            const float* modl = mod + (size_t)l * 5 * 9216;
            if (k == 0 || k == 9) {
                const int j = k ? 1 : 0;
                pg8::Gemm g{(const bf16_t*)(ws + WS_U), (const bf16_t*)(ws + WS_WGU + (size_t)j * 5632 * 1024), NTOK, 5632, DM / 2};
                pg8::StaticOrder S; S.init(NTOK, 5632, ogd(), obx());
                EpiSwiGLU E{(unsigned char*)(ws + WS_H)};
                pg8::gemm_phase<EpiSwiGLU, true>(wv, lds, g, S, E);
                if (DUP_K == 0 && k == 0) pg8::gemm_phase<EpiSwiGLU, true>(wv, lds, g, S, E);
            } else if (k == 1 || k == 10) {
                const int j = (k == 10) ? 1 : 0;
                pg8::Gemm g{(const bf16_t*)(ws + WS_H), (const bf16_t*)(ws + WS_WD + (size_t)j * 1024 * 2816), NTOK, DM, DFF / 2};
                pg8::StaticOrder S; S.init(NTOK, DM, ogd(), obx());
                const int lnix = (j == 0 && l == 0) ? -1 : (j ? l * 3 + 1 : (l - 1) * 3 + 2);
                EpiResid E{X, modl, (const float*)(ws + WS_ST), j ? 8 : 2, 0.5f / WD_SCALE, lnix, 0};
                pg8::gemm_phase<EpiResid, true>(wv, lds, g, S, E);
                if (DUP_K == 103) { EpiDiscard E2{(float*)(ws + WS_BAR + 8192)}; pg8::gemm_phase<EpiDiscard, true>(wv, lds, g, S, E2); }
            } else if (k == 2) ln_phase(wv, p, ws, out, l, 0, l, 1, false);
            else if (k == 3) {
                pg8::Gemm g{(const bf16_t*)(ws + WS_U), (const bf16_t*)(ws + WS_WIN), NTOK, 1792, DM};
                pg8::StaticOrder S; S.init(NTOK, 1792, ogd(), obx());
                EpiZ E{(bf16_t*)(ws + WS_H)};
                pg8::gemm_phase(wv, lds, g, S, E);
                if (DUP_K == 3) pg8::gemm_phase(wv, lds, g, S, E);
            } else if (k == 4) { post_phase(wv, p, ws, out, l, lds); if (DUP_K == 4) post_phase(wv, p, ws, out, l, lds); }
            else if (k == 5) {
                { pg8::Gemm g{(const bf16_t*)(ws + WS_XCB), (const bf16_t*)(ws + WS_WLRU), NTOK, 1024, 256};
                  pg8::StaticOrder S; S.init(NTOK, 1024, ogd(), obx());
                  EpiLru E{(const bf16_t*)(ws + WS_XCB), (bf16_t*)(ws + WS_A), (bf16_t*)(ws + WS_UU), INP(p, 21) + l * 512, INP(p, 23) + l * 512, (const float*)(ws + WS_SPT) + l * 512};
                  pg8::gemm_phase(wv, lds, g, S, E); }
                { pg8::Gemm g{(const bf16_t*)(ws + WS_CQN), (const bf16_t*)(ws + WS_WUQ), NTOK, 512, 256};
                  pg8::StaticOrder S; S.init(NTOK, 512, ogd(), (obx() + 128) & 255);
                  EpiQc E{(bf16_t*)(ws + WS_QC), (const f32x2*)(ws + WS_R32)};
                  pg8::gemm_phase(wv, lds, g, S, E); }
                { pg8::Gemm g{(const bf16_t*)(ws + WS_CKV), (const bf16_t*)(ws + WS_WUKV), NCKV, 512, 256};
                  const int cb_ = obx(); pg8::StaticOrder S; S.init(NCKV, 512, ogd(), cb_ >= 128 ? cb_ - 128 : (cb_ >= 64 ? cb_ + 64 : cb_ + 192));
                  EpiKv E{(bf16_t*)(ws + WS_KC), (bf16_t*)(ws + WS_VTC)};
                  pg8::gemm_phase(wv, lds, g, S, E); }
                if (DUP_K == 5) {
                { pg8::Gemm g{(const bf16_t*)(ws + WS_XCB), (const bf16_t*)(ws + WS_WLRU), NTOK, 1024, 256};
                  pg8::StaticOrder S; S.init(NTOK, 1024, ogd(), obx());
                  EpiLru E{(const bf16_t*)(ws + WS_XCB), (bf16_t*)(ws + WS_A), (bf16_t*)(ws + WS_UU), INP(p, 21) + l * 512, INP(p, 23) + l * 512, (const float*)(ws + WS_SPT) + l * 512};
                  pg8::gemm_phase(wv, lds, g, S, E); }
                { pg8::Gemm g{(const bf16_t*)(ws + WS_CQN), (const bf16_t*)(ws + WS_WUQ), NTOK, 512, 256};
                  pg8::StaticOrder S; S.init(NTOK, 512, ogd(), (obx() + 128) & 255);
                  EpiQc E{(bf16_t*)(ws + WS_QC), (const f32x2*)(ws + WS_R32)};
                  pg8::gemm_phase(wv, lds, g, S, E); }
                { pg8::Gemm g{(const bf16_t*)(ws + WS_CKV), (const bf16_t*)(ws + WS_WUKV), NCKV, 512, 256};
                  const int cb_ = obx(); pg8::StaticOrder S; S.init(NCKV, 512, ogd(), cb_ >= 128 ? cb_ - 128 : (cb_ >= 64 ? cb_ + 64 : cb_ + 192));
                  EpiKv E{(bf16_t*)(ws + WS_KC), (bf16_t*)(ws + WS_VTC)};
                  pg8::gemm_phase(wv, lds, g, S, E); }
                }
            } else if (k == 6) { mixer_phase(wv, p, ws, out, l, lds, 31); if (DUP_K == 6) mixer_phase(wv, p, ws, out, l, lds, DUP_SUB); }
            else if (k == 7) {
                pg8::Gemm g{(const bf16_t*)(ws + WS_U), (const bf16_t*)(ws + WS_WOUT), NTOK, DM, DM};
                pg8::StaticOrder S; S.init(NTOK, DM, ogd(), obx());
                EpiResid E{X, modl, (const float*)(ws + WS_ST), 5, 1.0f, l * 3, 0};
                pg8::gemm_phase(wv, lds, g, S, E);
            } else if (k == 8) ln_phase(wv, p, ws, out, l, 1, l, 2, false);
            else {
                ln_phase(wv, p, ws, out, l, 2, l + 1, (l + 1 < NLAYER) ? 0 : -1, false);
                if (l + 1 < NLAYER) weight_prep(wv, p, ws, l + 1, lds);
                if (DUP_K == 102 && l + 1 < NLAYER) { __syncthreads(); weight_prep(wv, p, ws, l + 1, lds); }
            }
        }
        if (ph + 1 < p.ph_hi) { if (p.ph_lo < 0) grid.sync(); else { xcd_barrier(wv, (unsigned*)(ws + WS_BAR), bst); if (DUP_K == 200) { xcd_barrier(wv, (unsigned*)(ws + WS_BAR), bst); xcd_barrier(wv, (unsigned*)(ws + WS_BAR), bst); } } }
    }
}

extern "C" void kernel_launch(void* const* d_in, const int* in_sizes, int n_in, void* d_out, int out_size, void* d_ws, size_t ws_size, hipStream_t stream) {
    static int grid = 0;
    if (grid == 0) {
        if (n_in != 32 || out_size != 38862848 || ws_size < WS_END) { fprintf(stderr, "kernel_launch: unexpected problem (n_in %d out %d ws %zu need %zu)\n", n_in, out_size, ws_size, (size_t)WS_END); grid = -1; return; }
        int dev = 0, cus = 0, per_cu = 0;
        hipGetDevice(&dev); hipDeviceGetAttribute(&cus, hipDeviceAttributeMultiprocessorCount, dev);
        hipFuncSetAttribute((const void*)fwd_megakernel, hipFuncAttributeMaxDynamicSharedMemorySize, LDS_BYTES);
        hipOccupancyMaxActiveBlocksPerMultiprocessor(&per_cu, (const void*)fwd_megakernel, 512, LDS_BYTES);
        (void)hipGetLastError();
        if (per_cu < 1) per_cu = 1;
        grid = cus;
        if (cus != 256) { fprintf(stderr, "kernel_launch: built for a 256-CU device (unit dealing assumes 256 workgroups), found %d CUs; nothing launched\n", cus); grid = -1; return; }
    }
    if (grid < 0) return;
    Params p{};
    for (int i = 0; i < 32; ++i) p.in[i] = (const float*)d_in[i];
    p.out = (float*)d_out; p.ws = (unsigned char*)d_ws;
    if (hipMemsetAsync((char*)d_ws + WS_BAR, 0, 16384, stream) != hipSuccess) { fprintf(stderr, "memset failed\n"); return; }
#if MK_PER_PHASE_LAUNCH
    for (int ph = 0; ph < N_PHASES; ++ph) {
        p.ph_lo = ph; p.ph_hi = ph + 1;
        void* args[] = {&p};
        hipError_t e = hipLaunchCooperativeKernel((void*)fwd_megakernel, dim3(grid), dim3(512), args, LDS_BYTES, stream);
        if (e != hipSuccess) { fprintf(stderr, "launch failed: %s\n", hipGetErrorString(e)); break; }
    }
#else
    p.ph_lo = 0; p.ph_hi = N_PHASES;
    void* args[] = {&p};
    hipError_t e = hipLaunchCooperativeKernel((void*)fwd_megakernel, dim3(grid), dim3(512), args, LDS_BYTES, stream);
    if (e != hipSuccess) fprintf(stderr, "cooperative launch failed: %s (grid %d)\n", hipGetErrorString(e), grid);
#endif
}
```

```cpp
#include <hip/hip_runtime.h>
#include <hip/hip_cooperative_groups.h>
#include <cstdio>
#include <cstdint>
namespace cg = cooperative_groups;

#ifndef MK_PER_PHASE_LAUNCH
#define MK_PER_PHASE_LAUNCH 0
#endif

#ifndef DUP_K
#define DUP_K -1
#endif
#ifndef DUP_SUB
#define DUP_SUB 31
#endif
#define LAS __attribute__((address_space(3)))
typedef unsigned short bf16_t;
typedef short bf16x8 __attribute__((ext_vector_type(8)));
typedef float f32x4 __attribute__((ext_vector_type(4)));
typedef float f32x2 __attribute__((ext_vector_type(2)));
typedef float f32x16 __attribute__((ext_vector_type(16)));
typedef unsigned u32x4 __attribute__((ext_vector_type(4)));
typedef unsigned u32x2 __attribute__((ext_vector_type(2)));
typedef int i32x4 __attribute__((ext_vector_type(4)));
typedef int i32x8 __attribute__((ext_vector_type(8)));

constexpr int DM = 1024, NTOK = 24576, NP = 8192, DFF = 2816, NLAYER = 4;
constexpr int SKV = 4352;
constexpr int NCKV = 25600;
constexpr int ZP = 1632;
constexpr float ALPHA = 1.681792830507429f;
constexpr float LOG2E = 1.4426950408889634f;
constexpr float C2G = 0.125f * LOG2E;
constexpr float C2C = 0.10206207261596575f * LOG2E;

constexpr size_t O_K = 25165824, O_V = 29360128, O_CKV = 33554432, O_KR = 37748736, O_LRU = 38797312;

constexpr size_t al256(size_t x) { return (x + 255) & ~(size_t)255; }
constexpr size_t WS_MOD = 0;
constexpr size_t WS_R64 = al256(WS_MOD + (size_t)4 * 5 * 9216 * 4);
constexpr size_t WS_R32 = WS_R64 + 64 * 16 * 8;
constexpr size_t WS_SPT = al256(WS_R32 + 64 * 8 * 8);
constexpr size_t WS_WGU = al256(WS_SPT + 4 * 512 * 4);
constexpr size_t WS_WD = WS_WGU + (size_t)2 * 5632 * 1024 * 2;
constexpr size_t WS_WIN = WS_WD + (size_t)2 * 1024 * 2816 * 2;
constexpr size_t WS_WOUT = WS_WIN + (size_t)1792 * 1024 * 2;
constexpr size_t WS_WLRU = WS_WOUT + (size_t)1024 * 1024 * 2;
constexpr size_t WS_WUQ = WS_WLRU + (size_t)1024 * 256 * 2;
constexpr size_t WS_WUKV = WS_WUQ + (size_t)512 * 256 * 2;
constexpr size_t WS_U = WS_WUKV + (size_t)512 * 256 * 2;
constexpr size_t WS_H = WS_U + (size_t)NTOK * 1024 * 2;
constexpr size_t WS_QG = WS_H + (size_t)NTOK * ZP * 4;
constexpr size_t WS_KG = WS_QG + (size_t)NTOK * 512 * 2;
constexpr size_t KG_S = (size_t)32 * 256 * 128;
constexpr size_t WS_VTG = WS_KG + (size_t)NCKV * 128 * 2;
constexpr size_t VTG_S = (size_t)64 * 64 * 256;
constexpr size_t WS_CQN = WS_VTG + (size_t)NCKV * 128 * 2;
constexpr size_t WS_CKV = WS_CQN + (size_t)NTOK * 256 * 2;
constexpr size_t WS_QC = WS_CKV + (size_t)NCKV * 256 * 2;
constexpr size_t WS_KC = WS_QC + (size_t)NTOK * 384 * 2;
constexpr size_t WS_VTC = WS_KC + (size_t)NCKV * 384 * 2;
constexpr size_t VTC_S = (size_t)128 * 64 * 256;
constexpr size_t WS_XCF = WS_VTC + (size_t)NCKV * 256 * 2;
constexpr size_t WS_XCB = WS_XCF + (size_t)NTOK * 256 * 4;
constexpr size_t WS_A = WS_H;
constexpr size_t WS_UU = WS_A + (size_t)NTOK * 512 * 4;
constexpr size_t WS_HF = WS_UU + (size_t)NTOK * 512 * 4;
constexpr size_t WS_HB = WS_HF + (size_t)NTOK * 256 * 4;
static_assert(WS_HB + (size_t)NTOK * 256 * 4 <= WS_H + (size_t)NTOK * ZP * 4, "scan buffers fit in the Z region");
constexpr size_t WS_GA = WS_XCB + (size_t)NTOK * 256 * 2;
constexpr size_t WS_ST = WS_GA + (size_t)NTOK * 256 * 4;
constexpr size_t WS_LNG = WS_ST + (size_t)NTOK * 8;
constexpr size_t WS_BAR = WS_LNG + (size_t)2 * 12 * 1024 * 4;
constexpr size_t WS_END = WS_BAR + 16384;
static_assert((size_t)NTOK * DFF * 2 <= (size_t)NTOK * ZP * 4, "H fits in the Z region");

constexpr int LDS_BYTES = 147456;

struct Params {
    const float* in[32];
    float* out;
    unsigned char* ws;
    int ph_lo, ph_hi;
};

__device__ __forceinline__ const float* INP(const Params& p, int i) { asm volatile("" : "+s"(i)); return p.in[i]; }
__device__ __forceinline__ unsigned f2bf(float f) { unsigned u = __builtin_bit_cast(unsigned, f); return (u + 0x7fffu + ((u >> 16) & 1u)) >> 16; }
typedef __bf16 bf16x2_t __attribute__((ext_vector_type(2)));
__device__ __forceinline__ unsigned pk2(float lo, float hi) { const f32x2 v = {lo, hi}; const bf16x2_t b = __builtin_convertvector(v, bf16x2_t); return __builtin_bit_cast(unsigned, b); }
__device__ __forceinline__ f32x4 bf4(u32x2 w) { return (f32x4){__builtin_bit_cast(float, w.x << 16), __builtin_bit_cast(float, w.x & 0xffff0000u), __builtin_bit_cast(float, w.y << 16), __builtin_bit_cast(float, w.y & 0xffff0000u)}; }
__device__ __forceinline__ unsigned pk4_fp8(float a, float b, float c, float d) {
    int w = __builtin_amdgcn_cvt_pk_fp8_f32(a, b, 0, false); w = __builtin_amdgcn_cvt_pk_fp8_f32(c, d, w, true); return (unsigned)w; }
constexpr float WGU_SCALE = 32.f, WD_SCALE = 128.f;
__device__ __forceinline__ float siluf(float x) { return x * __builtin_amdgcn_rcpf(1.f + __expf(-x)); }
__device__ __forceinline__ float sigmoidf_(float x) { return __builtin_amdgcn_rcpf(1.f + __expf(-x)); }
__device__ __forceinline__ float gelu_tanh(float x) {
    const float y = 0.7978845608028654f * (x + 0.044715f * x * x * x);
    const float e = __expf(2.f * y);
    const float th = 1.f - 2.f * __builtin_amdgcn_rcpf(e + 1.f);
    return 0.5f * x * (1.f + th);
}
__device__ __forceinline__ int obx() { int b = blockIdx.x; asm volatile("" : "+s"(b)); return b; }
__device__ __forceinline__ int ogd() { int b = gridDim.x; asm volatile("" : "+s"(b)); return b; }
__device__ __forceinline__ int olane() { int l; asm volatile("v_mbcnt_lo_u32_b32 %0, -1, 0\n\tv_mbcnt_hi_u32_b32 %0, -1, %0" : "=v"(l)); return l; }
__device__ __forceinline__ int otid(int wv) { int l; asm volatile("v_mbcnt_lo_u32_b32 %0, -1, 0\n\tv_mbcnt_hi_u32_b32 %0, -1, %0" : "=v"(l)); return wv * 64 + l; }
__device__ __forceinline__ float shx(float v, int mask, int lane) { return __builtin_bit_cast(float, __builtin_amdgcn_ds_bpermute((lane ^ mask) << 2, __builtin_bit_cast(int, v))); }
__device__ __forceinline__ float wave_sum(float v, int lane) {
#pragma unroll
    for (int o = 1; o < 64; o <<= 1) v += shx(v, o, lane);
    return v;
}
__device__ __forceinline__ float ozero() { float z = 0.f; asm volatile("" : "+v"(z)); return z; }

namespace pg8 {
constexpr int BM = 256, BK = 64, HALF = 128, HTB = HALF * BK * 2, STAGE_BYTES = 8 * HTB, NXCD = 8, WGM = 8;
__host__ __device__ __forceinline__ int lds_byte(int r, int c) { const int st = (r >> 4) * 2 + (c >> 5), rr = r & 15, cc = c & 31, ob = rr * 64 + cc * 2; return st * 1024 + (ob ^ (((ob >> 9) & 1) << 5)); }
__host__ __device__ __forceinline__ void stage_rc(int b, int& R, int& C) { const int st = b / 1024, sb = b % 1024, swz = sb ^ (((sb >> 9) & 1) << 5); R = (st >> 1) * 16 + swz / 64; C = (st & 1) * 32 + (swz % 64) / 2; }
__host__ __device__ __forceinline__ int perm32(int rho) { const int n = rho >> 4, i = rho & 15; return 8 * (i >> 2) + 4 * n + (i & 3); }
struct Unit { int pm, pn; };
struct Gemm { const bf16_t* A; const bf16_t* Bt; int M, N, K; };
struct StaticOrder {
    int nM, nN, nwg, G, c;
    __device__ __forceinline__ void init(int M, int N, int G_, int c_) { nM = M / BM; nN = N / BM; nwg = nM * nN; G = G_; c = c_; }
    __device__ __forceinline__ bool next(int i, Unit& u) const {
        const long L = (long)i * G + c; if (L >= nwg) return false;
        int wgid = (int)L; { const int q = nwg / NXCD, r = nwg % NXCD, xcd = wgid % NXCD, off = wgid / NXCD; wgid = (xcd < r ? xcd * (q + 1) : r * (q + 1) + (xcd - r) * q) + off; }
        const int nig = WGM * nN, gid = wgid / nig, fm = gid * WGM, gsz = (nM - fm) < WGM ? (nM - fm) : WGM;
        u.pm = fm + ((wgid % nig) % gsz); u.pn = (wgid % nig) / gsz; return true;
    }
};

__device__ __forceinline__ void glds16s(const void* sbase, unsigned voff, unsigned lds_dst) {
    unsigned keep;
    asm volatile("s_mov_b32 %0, m0\n\ts_mov_b32 m0, %3\n\ts_nop 0\n\tglobal_load_lds_dwordx4 %1, %2\n\ts_mov_b32 m0, %0" : "=&s"(keep) : "v"(voff), "s"(sbase), "s"(lds_dst) : "memory");
}
template <class Epi, bool FP8 = false>
__device__ __forceinline__ void gemm_phase(int wv, LAS unsigned char* lds, const Gemm g, const StaticOrder& S, const Epi& E) {
    const int tid = otid(wv), wid = __builtin_amdgcn_readfirstlane(tid >> 6), lane = tid & 63, wr = wid >> 2, wc = wid & 3, fr = lane & 15, fq = lane >> 4;
    const int K = g.K, nt = K / BK;
    unsigned voffA[2], voffB[2];
#pragma unroll
    for (int i = 0; i < 2; ++i) { int R, C; stage_rc(tid * 16 + i * 8192, R, C); const int Rb = Epi::PERM ? ((R & ~31) + perm32(R & 31)) : R;
        voffA[i] = (unsigned)(R * K + C) * 2u; voffB[i] = (unsigned)(Rb * K + C) * 2u; }
    const size_t kstep = (size_t)(BK * 2);
    const size_t hstep = (size_t)HALF * K * 2;
    const size_t tstep = 2 * hstep;
    const unsigned lds0 = (unsigned)__builtin_amdgcn_readfirstlane((int)((unsigned)(__UINTPTR_TYPE__)lds + (unsigned)wid * 1024u));
    const int aoff = lds_byte(wr * 64 + fr, fq * 8), boff = lds_byte(wc * 32 + fr, fq * 8);
#define PG8_SA(b, h) (((b) * 2 + (h)) * HTB)
#define PG8_SB(b, h) ((4 + (b) * 2 + (h)) * HTB)
#define PG8_STAGE(bufoff, gbase, voff) do { _Pragma("unroll") for (int _i = 0; _i < 2; ++_i) \
        glds16s((const void*)(gbase), (voff)[_i], lds0 + (unsigned)((bufoff) + _i * 8192)); } while (0)
#define PG8_LDA(dst, b, h) do { _Pragma("unroll") for (int m = 0; m < 4; ++m) _Pragma("unroll") for (int k = 0; k < 2; ++k) dst[m][k] = *(const LAS bf16x8*)(lds + PG8_SA(b, h) + aoff + m * 2048 + k * 1024); } while (0)
#define PG8_LDB(dst, b, h) do { _Pragma("unroll") for (int n = 0; n < 2; ++n) _Pragma("unroll") for (int k = 0; k < 2; ++k) dst[n][k] = *(const LAS bf16x8*)(lds + PG8_SB(b, h) + boff + n * 2048 + k * 1024); } while (0)
#define PG8_MMA(ai, bj, At, Bt) do { __builtin_amdgcn_s_setprio(1); _Pragma("unroll") for (int m = 0; m < 4; ++m) _Pragma("unroll") for (int n = 0; n < 2; ++n) { \
        if constexpr (FP8) { \
            const i32x8 b8_ = __builtin_shufflevector(__builtin_bit_cast(i32x4, Bt[n][0]), __builtin_bit_cast(i32x4, Bt[n][1]), 0, 1, 2, 3, 4, 5, 6, 7); \
            const i32x8 a8_ = __builtin_shufflevector(__builtin_bit_cast(i32x4, At[m][0]), __builtin_bit_cast(i32x4, At[m][1]), 0, 1, 2, 3, 4, 5, 6, 7); \
            acc[ai][bj][m][n] = __builtin_amdgcn_mfma_scale_f32_16x16x128_f8f6f4(b8_, a8_, acc[ai][bj][m][n], 0, 0, 0, 0, 0, 0); \
        } else { _Pragma("unroll") for (int k = 0; k < 2; ++k) \
            acc[ai][bj][m][n] = __builtin_amdgcn_mfma_f32_16x16x32_bf16(Bt[n][k], At[m][k], acc[ai][bj][m][n], 0, 0, 0); } } \
        __builtin_amdgcn_s_setprio(0); } while (0)
#define PG8_WAIT_V(n) asm volatile("s_waitcnt vmcnt(" #n ")" ::: "memory")
#define PG8_WAIT_L(n) asm volatile("s_waitcnt lgkmcnt(" #n ")" ::: "memory")
#define PG8_BAR __builtin_amdgcn_s_barrier()
#define PG8_SCHED __builtin_amdgcn_sched_barrier(0)
    Unit cur, nxt; int ui = 0;
    if (!S.next(0, cur)) return;
    f32x4 acc[2][2][4][2];
    { const float z = ozero();
#pragma unroll
    for (int a = 0; a < 2; ++a)
#pragma unroll
        for (int b = 0; b < 2; ++b)
#pragma unroll
            for (int m = 0; m < 4; ++m)
#pragma unroll
                for (int n = 0; n < 2; ++n) acc[a][b][m][n] = (f32x4){z, z, z, z}; }
    bf16x8 At[4][2], B0[2][2], B1[2][2];
    const char* cA = (const char*)g.A + (size_t)cur.pm * tstep; const char* cB = (const char*)g.Bt + (size_t)cur.pn * tstep;
    PG8_STAGE(PG8_SB(0, 0), cB, voffB); PG8_STAGE(PG8_SA(0, 0), cA, voffA); PG8_STAGE(PG8_SB(0, 1), cB + hstep, voffB); PG8_STAGE(PG8_SA(0, 1), cA + hstep, voffA);
    if (wr == 1) PG8_BAR;
    PG8_WAIT_V(4); PG8_BAR;
    PG8_STAGE(PG8_SB(1, 0), cB + kstep, voffB); PG8_STAGE(PG8_SA(1, 0), cA + kstep, voffA); PG8_STAGE(PG8_SB(1, 1), cB + hstep + kstep, voffB);
    PG8_WAIT_V(6); PG8_BAR;
    for (;;) {
        const bool has_next = S.next(ui + 1, nxt);
        const char* nA = has_next ? (const char*)g.A + (size_t)nxt.pm * tstep : cA; const char* nB = has_next ? (const char*)g.Bt + (size_t)nxt.pn * tstep : cB;
        for (int t = 0; t < nt; t += 2) {
            const bool last = (t == nt - 2);
            const char* a1 = cA + (size_t)(t + 1) * kstep;
            const char* a2 = last ? nA : cA + (size_t)(t + 2) * kstep; const char* b2 = last ? nB : cB + (size_t)(t + 2) * kstep;
            const char* a3 = a2 + kstep; const char* b3 = b2 + kstep;
            PG8_LDB(B0, 0, 0); PG8_SCHED; PG8_LDA(At, 0, 0); PG8_STAGE(PG8_SA(1, 1), a1 + hstep, voffA);
            PG8_WAIT_L(8); PG8_BAR; PG8_WAIT_L(0); PG8_MMA(0, 0, At, B0); PG8_BAR; PG8_SCHED;
            PG8_LDB(B1, 0, 1); PG8_STAGE(PG8_SB(0, 0), b2, voffB);
            PG8_BAR; PG8_WAIT_L(0); PG8_MMA(0, 1, At, B1); PG8_BAR;
            PG8_LDA(At, 0, 1); PG8_STAGE(PG8_SA(0, 0), a2, voffA);
            PG8_BAR; PG8_WAIT_L(0); PG8_MMA(1, 0, At, B0); PG8_BAR; PG8_SCHED;
            PG8_STAGE(PG8_SB(0, 1), b2 + hstep, voffB);
            PG8_WAIT_V(6); PG8_BAR; PG8_MMA(1, 1, At, B1); PG8_BAR;
            PG8_LDB(B0, 1, 0); PG8_SCHED; PG8_LDA(At, 1, 0); PG8_STAGE(PG8_SA(0, 1), a2 + hstep, voffA);
            PG8_WAIT_L(8); PG8_BAR; PG8_WAIT_L(0); PG8_MMA(0, 0, At, B0); PG8_BAR; PG8_SCHED;
            PG8_LDB(B1, 1, 1); PG8_STAGE(PG8_SB(1, 0), b3, voffB);
            PG8_BAR; PG8_WAIT_L(0); PG8_MMA(0, 1, At, B1); PG8_BAR;
            PG8_LDA(At, 1, 1); PG8_STAGE(PG8_SA(1, 0), a3, voffA);
            PG8_BAR; PG8_WAIT_L(0); PG8_MMA(1, 0, At, B0); PG8_BAR; PG8_SCHED;
            PG8_STAGE(PG8_SB(1, 1), b3 + hstep, voffB);
            PG8_WAIT_V(6); PG8_BAR; PG8_MMA(1, 1, At, B1); PG8_BAR;
        }
        E(acc, cur, wr, wc, fr, fq);
        if (!has_next) break;
        { const float z = ozero();
#pragma unroll
        for (int a = 0; a < 2; ++a)
#pragma unroll
            for (int b = 0; b < 2; ++b)
#pragma unroll
                for (int m = 0; m < 4; ++m)
#pragma unroll
                    for (int n = 0; n < 2; ++n) acc[a][b][m][n] = (f32x4){z, z, z, z}; }
        cur = nxt; cA = nA; cB = nB; ++ui;
    }
    PG8_WAIT_V(0);
    if (wr == 0) PG8_BAR;
    PG8_BAR;
#undef PG8_SA
#undef PG8_SB
#undef PG8_STAGE
#undef PG8_LDA
#undef PG8_LDB
#undef PG8_MMA
#undef PG8_WAIT_V
#undef PG8_WAIT_L
#undef PG8_BAR
#undef PG8_SCHED
}
}

typedef const f32x4 (&AccRef)[2][2][4][2];

struct EpiSwiGLU {
    static constexpr bool PERM = true;
    unsigned char* H;
    __device__ __forceinline__ void operator()(AccRef acc, const pg8::Unit& u, int wr, int wc, int fr, int fq) const {
        { const int l_ = olane(); fr = l_ & 15; fq = l_ >> 4; }
        const int row0 = u.pm * 256 + wr * 64 + fr, col0 = u.pn * 128 + wc * 32 + 8 * fq;
        constexpr float IS = 1.f / WGU_SCALE;
#pragma unroll
        for (int ai = 0; ai < 2; ++ai)
#pragma unroll
            for (int m = 0; m < 4; ++m) {
                unsigned char* rowp = H + (size_t)(row0 + ai * 128 + m * 16) * DFF + col0;
                const f32x4 g0 = acc[ai][0][m][0] * IS, g1 = acc[ai][0][m][1] * IS, u0 = acc[ai][1][m][0] * IS, u1 = acc[ai][1][m][1] * IS;
                u32x2 w;
                w.x = pk4_fp8(siluf(g0[0]) * u0[0], siluf(g0[1]) * u0[1], siluf(g0[2]) * u0[2], siluf(g0[3]) * u0[3]);
                w.y = pk4_fp8(siluf(g1[0]) * u1[0], siluf(g1[1]) * u1[1], siluf(g1[2]) * u1[2], siluf(g1[3]) * u1[3]);
                *(u32x2*)rowp = w;
            }
    }
};
struct EpiResid {
    static constexpr bool PERM = false;
    float* X; const float* modl; const float* st; int gidx; float gs; int lnix; int pad_;
    __device__ __forceinline__ void operator()(AccRef acc, const pg8::Unit& u, int wr, int wc, int fr, int fq) const {
        { const int l_ = olane(); fr = l_ & 15; fq = l_ >> 4; }
        const int row0 = u.pm * 256 + wr * 64 + fr, col0 = u.pn * 256 + wc * 32 + 4 * fq;
        const int grp = u.pm < 32 ? 0 : 1 + ((u.pm - 32) >> 4);
        const float* gp = modl + grp * 9216 + gidx * 1024 + col0;
        f32x4 gv[2][2], gl[2][2], bl[2][2];
        const int idn = lnix < 0; const float* lg = st + (WS_LNG - WS_ST) / 4 + (idn ? 0 : lnix) * 1024; const float* lb = lg + 12 * 1024;
#pragma unroll
        for (int bj = 0; bj < 2; ++bj)
#pragma unroll
            for (int n = 0; n < 2; ++n) { gv[bj][n] = *(const f32x4*)(gp + bj * 128 + n * 16) * gs;
                gl[bj][n] = *(const f32x4*)(lg + col0 + bj * 128 + n * 16) * ALPHA; if (idn) gl[bj][n] = (f32x4){ALPHA, ALPHA, ALPHA, ALPHA};
                bl[bj][n] = *(const f32x4*)(lb + col0 + bj * 128 + n * 16) * ALPHA; if (idn) bl[bj][n] = (f32x4){0.f, 0.f, 0.f, 0.f}; }
#pragma unroll
        for (int ai = 0; ai < 2; ++ai)
#pragma unroll
            for (int m = 0; m < 4; ++m) {
                const int row = row0 + ai * 128 + m * 16;
                const f32x2 ms = *(const f32x2*)(st + 2 * (size_t)row);
                float* rowp = X + (size_t)row * DM + col0;
#pragma unroll
                for (int bj = 0; bj < 2; ++bj)
#pragma unroll
                    for (int n = 0; n < 2; ++n) { f32x4* q = (f32x4*)(rowp + bj * 128 + n * 16); *q = ((*q - ms.x) * ms.y) * gl[bj][n] + bl[bj][n] + gv[bj][n] * acc[ai][bj][m][n]; }
            }
    }
};
struct EpiDiscard {
    static constexpr bool PERM = false;
    float* sink;
    __device__ __forceinline__ void operator()(AccRef acc, const pg8::Unit& u, int wr, int wc, int fr, int fq) const {
        f32x4 t = acc[0][0][0][0];
#pragma unroll
        for (int ai = 0; ai < 2; ++ai)
#pragma unroll
            for (int bj = 0; bj < 2; ++bj)
#pragma unroll
                for (int m = 0; m < 4; ++m)
#pragma unroll
                    for (int n = 0; n < 2; ++n) t = t + acc[ai][bj][m][n];
        if (t.x + t.y + t.z + t.w == 1.2345678e33f) *sink = t.x;
    }
};
struct EpiZ {
    static constexpr bool PERM = true;
    bf16_t* Z;
    __device__ __forceinline__ void operator()(AccRef acc, const pg8::Unit& u, int wr, int wc, int fr, int fq) const {
        { const int l_ = olane(); fr = l_ & 15; fq = l_ >> 4; }
        const int row0 = u.pm * 256 + wr * 64 + fr, col0 = u.pn * 256 + wc * 32 + 8 * fq;
#pragma unroll
        for (int ai = 0; ai < 2; ++ai)
#pragma unroll
            for (int m = 0; m < 4; ++m) {
                bf16_t* rowp = Z + (size_t)(row0 + ai * 128 + m * 16) * ZP + col0;
#pragma unroll
                for (int bj = 0; bj < 2; ++bj) if (col0 + bj * 128 < ZP) {
                    const f32x4 v0 = acc[ai][bj][m][0], v1 = acc[ai][bj][m][1];
                    u32x4 w; w.x = pk2(v0[0], v0[1]); w.y = pk2(v0[2], v0[3]); w.z = pk2(v1[0], v1[1]); w.w = pk2(v1[2], v1[3]);
                    *(u32x4*)(rowp + bj * 128) = w; }
            }
    }
};
struct EpiLru {
    static constexpr bool PERM = false;
    const bf16_t* xcb; float* A; bf16_t* U; const float* ba; const float* bi; const float* lam;
    __device__ __forceinline__ void operator()(AccRef acc, const pg8::Unit& u, int wr, int wc, int fr, int fq) const {
        { const int l_ = olane(); fr = l_ & 15; fq = l_ >> 4; }
        const int row0 = u.pm * 256 + wr * 64 + fr;
#pragma unroll
        for (int n = 0; n < 2; ++n) {
            const int combo = u.pn * 128 + wc * 32 + 16 * n + 4 * fq, ch = combo & 255;
            const f32x4 bav = *(const f32x4*)(ba + combo), biv = *(const f32x4*)(bi + combo), sp = *(const f32x4*)(lam + combo);
#pragma unroll
            for (int ai = 0; ai < 2; ++ai)
#pragma unroll
                for (int m = 0; m < 4; ++m) {
                    const size_t row = (size_t)(row0 + ai * 128 + m * 16);
                    const f32x4 xc = bf4(*(const u32x2*)(xcb + row * 256 + ch));
                    const f32x4 ra = acc[ai][0][m][n], ri = acc[ai][1][m][n];
                    f32x4 av, uv;
#pragma unroll
                    for (int j = 0; j < 4; ++j) {
                        const float r = sigmoidf_(ra[j] + bav[j]), ig = sigmoidf_(ri[j] + biv[j]);
                        const float la = r * sp[j];
                        av[j] = __expf(la);
                        const float x2 = 2.f * la;
                        const float om = (x2 > -0.1f) ? -x2 * (1.f + 0.5f * x2 * (1.f + (1.f / 3.f) * x2 * (1.f + 0.25f * x2 * (1.f + 0.2f * x2)))) : 1.f - av[j] * av[j];
                        uv[j] = sqrtf(om) * ig * xc[j];
                    }
                    { const size_t ai_ = (((size_t)(combo >> 3) * NTOK + row) << 3) + (combo & 7); *(f32x4*)(A + ai_) = av; u32x2 uw; uw.x = pk2(uv[0], uv[1]); uw.y = pk2(uv[2], uv[3]); *(u32x2*)(U + ai_) = uw; }
                    asm volatile("" ::: "memory");
                }
        }
    }
};
struct EpiQc {
    static constexpr bool PERM = false;
    bf16_t* Qc; const f32x2* r32t;
    __device__ __forceinline__ void operator()(AccRef acc, const pg8::Unit& u, int wr, int wc, int fr, int fq) const {
        { const int l_ = olane(); fr = l_ & 15; fq = l_ >> 4; }
        const int row0 = u.pm * 256 + wr * 64 + fr;
#pragma unroll
        for (int bj = 0; bj < 2; ++bj) {
            const int G = u.pn * 8 + bj * 4 + wc;
            if (G >= 12) continue;
            const bool isrope = (G % 3) == 2;
#pragma unroll
            for (int ai = 0; ai < 2; ++ai)
#pragma unroll
                for (int m = 0; m < 4; ++m) {
                    const int row = row0 + ai * 128 + m * 16;
                    f32x4 x0 = acc[ai][bj][m][0], x1 = acc[ai][bj][m][1];
                    if (isrope && row >= NP) {
                        const int t = (row - NP) & 4095; const int pos = (fq < 2) ? (t >> 6) : (t & 63);
                        const f32x2* cs = r32t + pos * 8 + 4 * (fq & 1);
#pragma unroll
                        for (int j = 0; j < 4; ++j) { const f32x2 c = cs[j]; const float a = x0[j], b = x1[j]; x0[j] = a * c.x - b * c.y; x1[j] = a * c.y + b * c.x; }
                    }
                    bf16_t* op = Qc + (size_t)row * 384 + G * 32 + 4 * fq;
                    u32x2 w0, w1; w0.x = pk2(x0[0] * C2C, x0[1] * C2C); w0.y = pk2(x0[2] * C2C, x0[3] * C2C); w1.x = pk2(x1[0] * C2C, x1[1] * C2C); w1.y = pk2(x1[2] * C2C, x1[3] * C2C);
                    *(u32x2*)op = w0; *(u32x2*)(op + 16) = w1;
                    asm volatile("" ::: "memory");
                }
        }
    }
};
struct EpiKv {
    static constexpr bool PERM = false;
    bf16_t* Kc; bf16_t* Vtc;
    __device__ __forceinline__ void operator()(AccRef acc, const pg8::Unit& u, int wr, int wc, int fr, int fq) const {
        { const int l_ = olane(); fr = l_ & 15; fq = l_ >> 4; }
        const int rl = wr * 64 + fr;
        if (u.pn == 0) {
            bf16_t* kb = Kc + ((size_t)u.pm * 256 + rl) * 384 + 4 * fq;
#pragma unroll
            for (int ai = 0; ai < 2; ++ai)
#pragma unroll
                for (int m = 0; m < 4; ++m)
#pragma unroll
                    for (int bj = 0; bj < 2; ++bj)
#pragma unroll
                        for (int n = 0; n < 2; ++n) {
                            const int c = bj * 128 + wc * 32 + 16 * n, h = c >> 6, e = c & 63;
                            const f32x4 v = acc[ai][bj][m][n];
                            u32x2 w; w.x = pk2(v[0], v[1]); w.y = pk2(v[2], v[3]);
                            *(u32x2*)(kb + (size_t)(ai * 128 + m * 16) * 384 + h * 96 + e) = w;
                        }
        } else {
            bf16_t* vb = Vtc + ((size_t)u.pm * 256 + rl) * 256 + 4 * fq;
#pragma unroll
            for (int ai = 0; ai < 2; ++ai)
#pragma unroll
                for (int m = 0; m < 4; ++m)
#pragma unroll
                    for (int bj = 0; bj < 2; ++bj)
#pragma unroll
                        for (int n = 0; n < 2; ++n) {
                            const f32x4 v = acc[ai][bj][m][n];
                            u32x2 w; w.x = pk2(v[0], v[1]); w.y = pk2(v[2], v[3]);
                            *(u32x2*)(vb + (size_t)(ai * 128 + m * 16) * 256 + bj * 128 + wc * 32 + 16 * n) = w;
                        }
        }
    }
};

__device__ __forceinline__ float max3f(float a, float b, float c) { float r; asm("v_max3_f32 %0, %1, %2, %3" : "=v"(r) : "v"(a), "v"(b), "v"(c)); return r; }
__device__ __forceinline__ float max2f(float a, float b) { float r; asm("v_max_f32_e32 %0, %1, %2" : "=v"(r) : "v"(a), "v"(b)); return r; }
template <int DQ>
__device__ __forceinline__ void attn_unit(int wv, LAS unsigned char* lds, const bf16_t* Qp, int qpitch, const bf16_t* Kp, int kpitch, const bf16_t* Vp, int vpitch, int S, bf16_t* Op, int opitch) {
    constexpr int KROW = DQ * 2 + 16, VROW = 192, KT = 64 * KROW, VT = 64 * VROW, KCH = DQ / 8, ND = DQ / 16;
    const int tid = otid(wv), lane = tid & 63, wid = tid >> 6, r32 = lane & 31, hi = lane >> 5;
    const bf16_t* qrow = Qp + (size_t)(wid * 32 + r32) * qpitch;
    bf16x8 qr[ND];
#pragma unroll
    for (int d0 = 0; d0 < ND; ++d0) qr[d0] = *(const bf16x8*)(qrow + d0 * 16 + hi * 8);
    const int krow0 = tid / KCH, kch0 = tid % KCH;
    const int krow1 = (tid + 512) / KCH, kch1 = (tid + 512) % KCH;
    const bool k2 = (DQ > 64) && (tid + 512 < 64 * KCH);
    const int vrow = tid >> 3, vch = tid & 7;
    const bf16_t* ksrc0 = Kp + (size_t)krow0 * kpitch + kch0 * 8;
    const bf16_t* ksrc1 = Kp + (size_t)krow1 * kpitch + kch1 * 8;
    const bf16_t* vsrc = Vp + (size_t)vrow * vpitch + vch * 8;
    const int kdst0 = krow0 * KROW + kch0 * 16, kdst1 = krow1 * KROW + kch1 * 16, vdst = 2 * KT + vrow * VROW + vch * 16;
    const int pr = (r32 & ~12) | ((r32 & 4) << 1) | ((r32 & 8) >> 1);
    const int kaddr = pr * KROW + hi * 16, vaddr = 2 * KT + (8 * hi + ((lane & 15) >> 2)) * VROW + (16 * ((lane >> 4) & 1) + 4 * (lane & 3)) * 2;
    const int NT = S / 64;
    u32x4 kr0, kr1 = (u32x4){0, 0, 0, 0}, vr;
    kr0 = *(const u32x4*)ksrc0; if (k2) kr1 = *(const u32x4*)ksrc1; vr = *(const u32x4*)vsrc;
    *(LAS u32x4*)(lds + kdst0) = kr0; if (k2) *(LAS u32x4*)(lds + kdst1) = kr1; *(LAS u32x4*)(lds + vdst) = vr;
    kr0 = *(const u32x4*)(ksrc0 + (size_t)64 * kpitch); if (k2) kr1 = *(const u32x4*)(ksrc1 + (size_t)64 * kpitch);
    *(LAS u32x4*)(lds + KT + kdst0) = kr0; if (k2) *(LAS u32x4*)(lds + KT + kdst1) = kr1;
    __syncthreads();
    float mref = 0.f, lrun = 0.f;
    f32x16 o0 = {}, o1 = {}, p0 = {}, p1 = {}, negm = {};
#pragma unroll
    for (int d0 = 0; d0 < ND; ++d0) {
        const bf16x8 ka = *(const LAS bf16x8*)(lds + kaddr + d0 * 32);
        const bf16x8 kb = *(const LAS bf16x8*)(lds + kaddr + 32 * KROW + d0 * 32);
        p0 = __builtin_amdgcn_mfma_f32_32x32x16_bf16(ka, qr[d0], p0, 0, 0, 0);
        p1 = __builtin_amdgcn_mfma_f32_32x32x16_bf16(kb, qr[d0], p1, 0, 0, 0);
    }
#pragma unroll 2
    for (int t = 0; t < NT; ++t) {
        const int cur = t & 1;
        const bool more1 = (t + 1 < NT), more2 = (t + 2 < NT);
        if (more2) { kr0 = *(const u32x4*)(ksrc0 + (size_t)(t + 2) * 64 * kpitch); if (k2) kr1 = *(const u32x4*)(ksrc1 + (size_t)(t + 2) * 64 * kpitch); }
        if (more1) vr = *(const u32x4*)(vsrc + (size_t)(t + 1) * 64 * vpitch);
        float rm = max3f(p0[0], p1[0], p0[1]);
        rm = max3f(rm, p1[1], p0[2]);
#pragma unroll
        for (int r = 2; r < 15; ++r) rm = max3f(rm, p1[r], p0[r + 1]);
        rm = max2f(rm, p1[15]);
        rm = max2f(rm, shx(rm, 32, lane));
        if (t == 0 || __builtin_amdgcn_ballot_w64(rm > 10.f) != 0ull) {
            const float dl = (t == 0) ? rm : max2f(rm, 0.f);
            mref += dl;
            const float al = __builtin_amdgcn_exp2f(-dl);
            lrun *= al;
#pragma unroll
            for (int r = 0; r < 16; ++r) { o0[r] *= al; o1[r] *= al; p0[r] -= dl; p1[r] -= dl; negm[r] = -mref; }
        }
        f32x16 n0 = negm, n1 = negm;
        {
            __builtin_amdgcn_s_setprio(1);
            LAS unsigned char* kb_ = lds + (cur ^ 1) * KT;
#pragma unroll
            for (int d0 = 0; d0 < ND; ++d0) {
                const bf16x8 ka = *(const LAS bf16x8*)(kb_ + kaddr + d0 * 32);
                const bf16x8 kb = *(const LAS bf16x8*)(kb_ + kaddr + 32 * KROW + d0 * 32);
                n0 = __builtin_amdgcn_mfma_f32_32x32x16_bf16(ka, qr[d0], n0, 0, 0, 0);
                n1 = __builtin_amdgcn_mfma_f32_32x32x16_bf16(kb, qr[d0], n1, 0, 0, 0);
            }
        }
        __builtin_amdgcn_s_setprio(0);
        float ls = 0.f;
#pragma unroll
        for (int r = 0; r < 16; ++r) { p0[r] = __builtin_amdgcn_exp2f(p0[r]); p1[r] = __builtin_amdgcn_exp2f(p1[r]); ls += p0[r] + p1[r]; }
        lrun += ls;
#pragma unroll
        for (int i_ = 0; i_ < 2 * ND; ++i_) { __builtin_amdgcn_sched_group_barrier(0x008, 1, 0); __builtin_amdgcn_sched_group_barrier(0x002, 64 / (2 * ND) + 2, 0); }
        bf16x8 pp[4];
#pragma unroll
        for (int s2 = 0; s2 < 2; ++s2) {
            u32x4 w; w.x = pk2(p0[8 * s2 + 0], p0[8 * s2 + 1]); w.y = pk2(p0[8 * s2 + 2], p0[8 * s2 + 3]); w.z = pk2(p0[8 * s2 + 4], p0[8 * s2 + 5]); w.w = pk2(p0[8 * s2 + 6], p0[8 * s2 + 7]);
            pp[s2] = __builtin_bit_cast(bf16x8, w);
            u32x4 w2; w2.x = pk2(p1[8 * s2 + 0], p1[8 * s2 + 1]); w2.y = pk2(p1[8 * s2 + 2], p1[8 * s2 + 3]); w2.z = pk2(p1[8 * s2 + 4], p1[8 * s2 + 5]); w2.w = pk2(p1[8 * s2 + 6], p1[8 * s2 + 7]);
            pp[2 + s2] = __builtin_bit_cast(bf16x8, w2);
        }
        {
            LAS unsigned char* vb_ = lds + cur * VT;
#pragma unroll
            for (int s2 = 0; s2 < 4; ++s2) {
                typedef short v4i16_t __attribute__((ext_vector_type(4)));
                LAS unsigned char* vp_ = vb_ + vaddr + s2 * 16 * VROW;
                const v4i16_t a0 = __builtin_amdgcn_ds_read_tr16_b64_v4i16((LAS v4i16_t*)(vp_)), a1 = __builtin_amdgcn_ds_read_tr16_b64_v4i16((LAS v4i16_t*)(vp_ + 4 * VROW));
                const v4i16_t b0 = __builtin_amdgcn_ds_read_tr16_b64_v4i16((LAS v4i16_t*)(vp_ + 64)), b1 = __builtin_amdgcn_ds_read_tr16_b64_v4i16((LAS v4i16_t*)(vp_ + 4 * VROW + 64));
                const bf16x8 va = (bf16x8){a0[0], a0[1], a0[2], a0[3], a1[0], a1[1], a1[2], a1[3]};
                const bf16x8 vb = (bf16x8){b0[0], b0[1], b0[2], b0[3], b1[0], b1[1], b1[2], b1[3]};
                o0 = __builtin_amdgcn_mfma_f32_32x32x16_bf16(va, pp[s2], o0, 0, 0, 0);
                o1 = __builtin_amdgcn_mfma_f32_32x32x16_bf16(vb, pp[s2], o1, 0, 0, 0);
            }
        }
        if (more2) { *(LAS u32x4*)(lds + cur * KT + kdst0) = kr0; if (k2) *(LAS u32x4*)(lds + cur * KT + kdst1) = kr1; }
        if (more1) *(LAS u32x4*)(lds + (cur ^ 1) * VT + vdst) = vr;
        __syncthreads();
        p0 = n0; p1 = n1;
    }
    const float ltot = lrun + shx(lrun, 32, lane);
    const float inv = 1.f / ltot;
    bf16_t* orow = Op + (size_t)(wid * 32 + r32) * opitch;
#pragma unroll
    for (int g = 0; g < 4; ++g) {
        u32x2 w; w.x = pk2(o0[4 * g] * inv, o0[4 * g + 1] * inv); w.y = pk2(o0[4 * g + 2] * inv, o0[4 * g + 3] * inv);
        *(u32x2*)(orow + 8 * g + 4 * hi) = w;
        u32x2 w2; w2.x = pk2(o1[4 * g] * inv, o1[4 * g + 1] * inv); w2.y = pk2(o1[4 * g + 2] * inv, o1[4 * g + 3] * inv);
        *(u32x2*)(orow + 32 + 8 * g + 4 * hi) = w2;
    }
}

template <int NCH>
__device__ __forceinline__ void scan_unit(int wv, LAS unsigned char* lds, const float* A, bf16_t* HF, bf16_t* HB, const bf16_t* U, const bf16_t* GA, bf16_t* MIX, size_t row0, int T,
                                          const float* h0f, const float* h0b, float* outf, float* outb, int c0) {
    constexpr int NCK = 512 / NCH, BT = 16;
    LAS float* sPf = (LAS float*)lds; LAS float* sHf = sPf + 512; LAS float* sPb = sPf + 1024; LAS float* sHb = sPf + 1536;
    const int tid = otid(wv), cl = tid & (NCH - 1), c = c0 + cl, k = tid / NCH, L = T / NCK;
    const size_t rbase = row0 + (size_t)k * L;
    const size_t of_ = (((size_t)(c >> 3) * NTOK + rbase) << 3) + (c & 7), ob_ = of_ + (size_t)32 * NTOK * 8;
    const float* af = A + of_; const bf16_t* uf = U + of_;
    const float* ab = A + ob_; const bf16_t* ub = U + ob_;
    float hf = 0.f, Pf = 1.f, hb = 0.f, Pb = 1.f;
    for (int i = 0; i < L; i += BT) {
        float a[BT], u[BT], a2[BT], u2[BT];
#pragma unroll
        for (int j = 0; j < BT; ++j) { a[j] = af[(i + j) * 8]; u[j] = __builtin_bit_cast(float, (unsigned)uf[(i + j) * 8] << 16); a2[j] = ab[(L - 1 - i - j) * 8]; u2[j] = __builtin_bit_cast(float, (unsigned)ub[(L - 1 - i - j) * 8] << 16); }
#pragma unroll
        for (int j = 0; j < BT; ++j) { hf = a[j] * hf + u[j]; Pf *= a[j]; hb = a2[j] * hb + u2[j]; Pb *= a2[j]; }
    }
    sPf[tid] = Pf; sHf[tid] = hf; sPb[tid] = Pb; sHb[tid] = hb;
    __syncthreads();
    hf = h0f ? h0f[c] : 0.f; hb = h0b ? h0b[c] : 0.f;
    for (int kk = 0; kk < k; ++kk) hf = sPf[kk * NCH + cl] * hf + sHf[kk * NCH + cl];
    for (int kk = NCK - 1; kk > k; --kk) hb = sPb[kk * NCH + cl] * hb + sHb[kk * NCH + cl];
    bf16_t* hfp = HF + of_; bf16_t* hbp = HB + of_;
    for (int i = 0; i < L; i += BT) {
        float a[BT], u[BT], a2[BT], u2[BT];
#pragma unroll
        for (int j = 0; j < BT; ++j) { a[j] = af[(i + j) * 8]; u[j] = __builtin_bit_cast(float, (unsigned)uf[(i + j) * 8] << 16); a2[j] = ab[(L - 1 - i - j) * 8]; u2[j] = __builtin_bit_cast(float, (unsigned)ub[(L - 1 - i - j) * 8] << 16); }
#pragma unroll
        for (int j = 0; j < BT; ++j) { hf = a[j] * hf + u[j]; hfp[(i + j) * 8] = (bf16_t)f2bf(hf); hb = a2[j] * hb + u2[j]; hbp[(L - 1 - i - j) * 8] = (bf16_t)f2bf(hb); }
    }
    if (outf && k == NCK - 1) outf[c] = hf;
    if (outb && k == 0) outb[c] = hb;
    const bf16_t* gp = GA + of_; bf16_t* mp = MIX + rbase * 1024 + c;
    for (int i = 0; i < L; i += BT) {
        float x[BT], y[BT], g[BT];
#pragma unroll
        for (int j = 0; j < BT; ++j) { x[j] = __builtin_bit_cast(float, (unsigned)hfp[(i + j) * 8] << 16); y[j] = __builtin_bit_cast(float, (unsigned)hbp[(i + j) * 8] << 16); g[j] = __builtin_bit_cast(float, (unsigned)gp[(i + j) * 8] << 16); }
#pragma unroll
        for (int j = 0; j < BT; ++j) mp[(size_t)(i + j) * 1024] = (bf16_t)f2bf(g[j] * (x[j] + y[j]));
    }
    __syncthreads();
}

__device__ __forceinline__ void transpose_item(const float* W, int K, int N, bf16_t* WT, LAS float* scr, int item, int lane, int mode, float f8scale = 0.f) {
    const int nblk = N / 32, kb = item / nblk, nb = item % nblk, k0 = 64 * kb, n0 = 32 * nb;
#pragma unroll 8
    for (int i = 0; i < 32; ++i) { const int kk = 2 * i + (lane >> 5); scr[kk * 33 + (lane & 31)] = W[(size_t)(k0 + kk) * N + n0 + (lane & 31)]; }
    asm volatile("s_waitcnt lgkmcnt(0)" ::: "memory");
    const int c = lane & 7;
#pragma unroll
    for (int j = 0; j < 4; ++j) {
        const int nl = (lane >> 3) + 8 * j; const LAS float* s = scr + (8 * c) * 33 + nl;
        u32x4 o; o.x = pk2(s[0 * 33], s[1 * 33]); o.y = pk2(s[2 * 33], s[3 * 33]); o.z = pk2(s[4 * 33], s[5 * 33]); o.w = pk2(s[6 * 33], s[7 * 33]);
        const int n = n0 + nl;
        const int dr = (mode == 0) ? n : ((n >> 7) * 256 + (mode == 2 ? 128 : 0) + (n & 127));
        if (f8scale != 0.f) { u32x2 o8; o8.x = pk4_fp8(s[0 * 33] * f8scale, s[1 * 33] * f8scale, s[2 * 33] * f8scale, s[3 * 33] * f8scale); o8.y = pk4_fp8(s[4 * 33] * f8scale, s[5 * 33] * f8scale, s[6 * 33] * f8scale, s[7 * 33] * f8scale);
            *(u32x2*)((unsigned char*)WT + (size_t)dr * K + k0 + 8 * c) = o8; }
        else *(u32x4*)(WT + (size_t)dr * K + k0 + 8 * c) = o;
    }
    asm volatile("s_waitcnt lgkmcnt(0)" ::: "memory");
}

__device__ __forceinline__ void weight_prep(int wv, const Params& p, unsigned char* ws, int l, LAS unsigned char* lds) {
    const int tid = otid(wv), lane = tid & 63, wave = tid >> 6;
    LAS float* scr = (LAS float*)(lds + wave * 8704);
    const int gw = obx() * 8 + wave, NGW = ogd() * 8;
    bf16_t* Wgu = (bf16_t*)(ws + WS_WGU); bf16_t* Wd = (bf16_t*)(ws + WS_WD); bf16_t* Win = (bf16_t*)(ws + WS_WIN); bf16_t* Wout = (bf16_t*)(ws + WS_WOUT);
    constexpr int I_G = 16 * 88, I_D = 44 * 32, I_IN = 16 * 51, I_OUT = 16 * 32;
    constexpr int NIT = 2 * (2 * I_G + I_D) + I_IN + I_OUT;
    for (int it = gw; it < NIT; it += NGW) {
        int r = it;
        if (r < 2 * (2 * I_G + I_D)) {
            const int j = r / (2 * I_G + I_D); r -= j * (2 * I_G + I_D);
            const size_t wo = (size_t)(l * 2 + j) * DM * DFF;
            if (r < I_G) { transpose_item(INP(p, 13) + wo, DM, DFF, (bf16_t*)((unsigned char*)Wgu + (size_t)j * 5632 * 1024), scr, r, lane, 1, WGU_SCALE); continue; } r -= I_G;
            if (r < I_G) { transpose_item(INP(p, 14) + wo, DM, DFF, (bf16_t*)((unsigned char*)Wgu + (size_t)j * 5632 * 1024), scr, r, lane, 2, WGU_SCALE); continue; } r -= I_G;
            transpose_item(INP(p, 15) + wo, DFF, DM, (bf16_t*)((unsigned char*)Wd + (size_t)j * 1024 * 2816), scr, r, lane, 0, WD_SCALE); continue;
        }
        r -= 2 * (2 * I_G + I_D);
        if (r < I_IN) { transpose_item(INP(p, 16) + (size_t)l * DM * ZP, DM, ZP, Win, scr, r, lane, 0); continue; } r -= I_IN;
        transpose_item(INP(p, 17) + (size_t)l * DM * DM, DM, DM, Wout, scr, r, lane, 0);
    }
    const size_t gt = (size_t)obx() * 512 + tid, NT = (size_t)ogd() * 512;
    bf16_t* Wlru = (bf16_t*)(ws + WS_WLRU); bf16_t* Wuq = (bf16_t*)(ws + WS_WUQ); bf16_t* Wukv = (bf16_t*)(ws + WS_WUKV);
    for (size_t i = gt; i < (size_t)160 * 1024; i += NT) Win[(size_t)ZP * 1024 + i] = 0;
    for (size_t i = gt; i < (size_t)1024 * 256; i += NT) {
        const int n = (int)(i >> 8), k = (int)(i & 255);
        const int pn = n >> 8, bj = (n >> 7) & 1, jl = n & 127, combo = pn * 128 + jl, dir = combo >> 8, ch = combo & 255, blk = ch >> 6, jj = ch & 63;
        float v = 0.f;
        if ((k >> 6) == blk) v = (bj ? INP(p, 22) : INP(p, 20))[((((size_t)l * 2 + dir) * 4 + blk) * 64 + (k & 63)) * 64 + jj];
        Wlru[i] = (bf16_t)f2bf(v);
    }
    for (size_t i = gt; i < (size_t)512 * 256; i += NT) {
        const int n = (int)(i >> 8), k = (int)(i & 255);
        float v = 0.f; if (n < 384 && k < 192) v = INP(p, 28)[((size_t)l * 192 + k) * 384 + n];
        Wuq[i] = (bf16_t)f2bf(v);
        float w = 0.f; if (k < 128) w = (n < 256) ? INP(p, 30)[((size_t)l * 128 + k) * 256 + n] : INP(p, 31)[((size_t)l * 128 + k) * 256 + (n - 256)];
        Wukv[i] = (bf16_t)f2bf(w);
    }
}

__device__ __forceinline__ void sincos_d(double r, float& c, float& s) {
    const double r2 = r * r; double ts = r, tc = 1.0, ss = r, cc = 1.0;
#pragma unroll 1
    for (int n = 1; n <= 14; ++n) { tc = -tc * r2 / (double)((2 * n - 1) * (2 * n)); ts = -ts * r2 / (double)((2 * n) * (2 * n + 1)); cc += tc; ss += ts; }
    c = (float)cc; s = (float)ss;
}

__device__ __forceinline__ void phase_prologue0(int wv, const Params& p, unsigned char* ws, LAS unsigned char* lds) {
    const int tid = otid(wv), lane = tid & 63, wave = tid >> 6;
    LAS float* sc = (LAS float*)lds;
    LAS float* red = sc + 5120;
    float* mod = (float*)(ws + WS_MOD);
    for (int idx = tid; idx < 5120; idx += 512) { const int g = idx >> 10, k = idx & 1023; const float v = (g == 0) ? INP(p, 8)[k] : INP(p, 7)[(g - 1) * 1024 + k]; sc[idx] = siluf(v); }
    __syncthreads();
    for (int item = obx(); item < 576; item += ogd()) {
        const int l = item / 144, cb = item % 144, n = cb * 64 + lane;
        const float* wp = INP(p, 9) + ((size_t)l * 1024 + wave * 128) * 9216 + n;
        float a0 = 0.f, a1 = 0.f, a2 = 0.f, a3 = 0.f, a4 = 0.f;
        for (int k = 0; k < 128; k += 8) {
            float w[8];
#pragma unroll
            for (int j = 0; j < 8; ++j) w[j] = wp[(size_t)(k + j) * 9216];
#pragma unroll
            for (int j = 0; j < 8; ++j) { const int kk = wave * 128 + k + j; a0 += sc[kk] * w[j]; a1 += sc[1024 + kk] * w[j]; a2 += sc[2048 + kk] * w[j]; a3 += sc[3072 + kk] * w[j]; a4 += sc[4096 + kk] * w[j]; }
        }
        red[(wave * 5 + 0) * 64 + lane] = a0; red[(wave * 5 + 1) * 64 + lane] = a1; red[(wave * 5 + 2) * 64 + lane] = a2; red[(wave * 5 + 3) * 64 + lane] = a3; red[(wave * 5 + 4) * 64 + lane] = a4;
        __syncthreads();
        if (tid < 320) { const int g = tid >> 6, ln = tid & 63; float s = INP(p, 10)[(size_t)l * 9216 + cb * 64 + ln];
#pragma unroll
            for (int w = 0; w < 8; ++w) s += red[(w * 5 + g) * 64 + ln];
            mod[((size_t)l * 5 + g) * 9216 + cb * 64 + ln] = s; }
        __syncthreads();
    }
    if (obx() == ogd() - 1) {
        f32x2* r64 = (f32x2*)(ws + WS_R64); f32x2* r32 = (f32x2*)(ws + WS_R32);
        { float* lgc = (float*)(ws + WS_LNG); const float* g0 = INP(p, 11); const float* b0 = INP(p, 12);
          for (int i = tid; i < 12 * 1024; i += 512) { lgc[i] = g0[i]; lgc[12 * 1024 + i] = b0[i]; } }
        float* spt = (float*)(ws + WS_SPT);
#pragma clang loop unroll(disable) vectorize(disable)
        for (int i = tid; i < 4 * 512; i += 512) {
            const float x = __expf(-INP(p, 24)[i]);
            const float sp_ = (x < 0.03125f) ? x * (1.f - x * (0.5f - x * ((1.f / 3.f) - x * (0.25f - 0.2f * x)))) : __logf(1.f + x);
            spt[i] = -8.f * sp_;
        }
        for (int i = tid; i < 64 * 16 + 64 * 8; i += 512) {
            int pos, f, nf; if (i < 1024) { pos = i >> 4; f = i & 15; nf = 16; } else { const int j = i - 1024; pos = j >> 3; f = j & 7; nf = 8; }
            const float inv = exp2f(-(float)f / (float)nf * 13.287712379549449f);
            const float ang = (float)pos * inv;
            const double kq = rint((double)ang * 0.15915494309189535); const double r = (double)ang - kq * 6.283185307179586476925;
            float c, s; sincos_d(r, c, s);
            if (i < 1024) r64[i] = (f32x2){c, s}; else r32[i - 1024] = (f32x2){c, s};
        }
    }
    __syncthreads();
    weight_prep(wv, p, ws, 0, lds);
}

__device__ __forceinline__ void ln_phase(int wv, const Params& p, unsigned char* ws, float* out, int l, int which, int lnext, int nextmod  , bool first_copy) {
    const int tid = otid(wv), lane = tid & 63, wave = tid >> 6;
    const int gw = obx() * 8 + wave, NGW = ogd() * 8;
    float* X = out; bf16_t* Ub = (bf16_t*)(ws + WS_U); const float* mod = (const float*)(ws + WS_MOD);
    float* stp = (float*)(ws + WS_ST);
    const float* lg = INP(p, 11) + ((size_t)l * 3 + which) * 1024; const float* lb = INP(p, 12) + ((size_t)l * 3 + which) * 1024;
    f32x4 gq[4], bq[4];
#pragma unroll
    for (int j = 0; j < 4; ++j) { gq[j] = *(const f32x4*)(lg + 4 * lane + 256 * j); bq[j] = *(const f32x4*)(lb + 4 * lane + 256 * j); }
    for (int row = gw; row < NTOK; row += NGW) {
        const float* src = first_copy ? (row < NP ? INP(p, 0) + (size_t)row * DM : INP(p, 1) + (size_t)(row - NP) * DM) : X + (size_t)row * DM;
        f32x4 v[4];
#pragma unroll
        for (int j = 0; j < 4; ++j) v[j] = *(const f32x4*)(src + 4 * lane + 256 * j);
        f32x4 shq[4], scq[4];
        {
            const int grp_ = row < NP ? 0 : 1 + ((row - NP) >> 12);
            const float* mp_ = mod + ((size_t)(nextmod < 0 ? 0 : lnext) * 5 + grp_) * 9216 + (nextmod < 0 ? 0 : nextmod) * 3 * 1024;
#pragma unroll
            for (int j = 0; j < 4; ++j) { shq[j] = *(const f32x4*)(mp_ + 4 * lane + 256 * j); scq[j] = *(const f32x4*)(mp_ + 1024 + 4 * lane + 256 * j); }
        }
        if (first_copy) { if (lane == 0) *(f32x2*)(stp + 2 * (size_t)row) = (f32x2){0.f, 1.f}; }
        if (!first_copy) {
            float s = 0.f;
#pragma unroll
            for (int j = 0; j < 4; ++j) s += (v[j].x + v[j].y) + (v[j].z + v[j].w);
            const float mean = wave_sum(s, lane) * (1.f / DM); float s2 = 0.f;
#pragma unroll
            for (int j = 0; j < 4; ++j) { v[j] = v[j] - mean; s2 += (v[j].x * v[j].x + v[j].y * v[j].y) + (v[j].z * v[j].z + v[j].w * v[j].w); }
            const float rstd = rsqrtf(wave_sum(s2, lane) * (1.f / DM) + 1e-6f);
            if (nextmod >= 0 && lane == 0) *(f32x2*)(stp + 2 * (size_t)row) = (f32x2){mean, rstd};
#pragma unroll
            for (int j = 0; j < 4; ++j) v[j] = v[j] * rstd * gq[j] + bq[j];
        }
        if (first_copy || nextmod < 0) {
#pragma unroll
            for (int j = 0; j < 4; ++j) *(f32x4*)(X + (size_t)row * DM + 4 * lane + 256 * j) = v[j];
        }
        if (nextmod >= 0) {
#pragma unroll
            for (int j = 0; j < 4; ++j) {
                const f32x4 u = v[j] * (scq[j] + 1.f) + shq[j];
                if (nextmod == 1) { u32x2 w; w.x = pk2(u.x, u.y); w.y = pk2(u.z, u.w); *(u32x2*)(Ub + (size_t)row * DM + 4 * lane + 256 * j) = w; }
                else *(unsigned*)((unsigned char*)Ub + (size_t)row * DM + 4 * lane + 256 * j) = pk4_fp8(u.x, u.y, u.z, u.w);
            }
        }
    }
}

struct PostRow { u32x2 cv0, cv1, cv2, cv3, gt, cq; u32x4 q, pz; f32x4 pa, pb; };

#define POST_DECODE \
        const bool cache = item >= NTOK; \
        int b, t, T; bool samp; size_t rowc; const int row = item; \
        if (cache) { const int r2 = item - NTOK; b = r2 >> 8; t = r2 & 255; T = 256; samp = true; rowc = (size_t)NP + (size_t)b * SKV + t; } \
        else if (row < NP) { b = row >> 8; t = row & 255; T = 256; samp = false; rowc = row; } \
        else { const int r2 = row - NP; b = r2 >> 12; t = r2 & 4095; T = 4096; samp = true; rowc = (size_t)NP + (size_t)b * SKV + 256 + t; } \
        const int grow = t >> 6, gcol = t & 63; \
        const bf16_t* z = Z + (size_t)row * ZP; (void)grow; (void)gcol; (void)rowc; (void)samp; (void)T;
__device__ __forceinline__ void post_load(const Params& p, unsigned char* ws, int l, int item, int lane, PostRow& R) {
    const bf16_t* Z = (const bf16_t*)(ws + WS_H);
    {
        POST_DECODE
        const u32x2 z2 = {0u, 0u};
        R.cv0 = z2; R.cv1 = z2; R.cv2 = z2; R.cv3 = z2; R.gt = z2; R.cq = z2; R.q = (u32x4){0u, 0u, 0u, 0u}; R.pz = (u32x4){0u, 0u, 0u, 0u};
        R.pa = (f32x4){0.f, 0.f, 0.f, 0.f}; R.pb = (f32x4){0.f, 0.f, 0.f, 0.f};
        if (!cache) {
            if (t - 1 >= 0) R.cv0 = *(const u32x2*)(z - ZP + 4 * lane);
            R.cv1 = *(const u32x2*)(z + 4 * lane);
            if (t + 1 < T) R.cv2 = *(const u32x2*)(z + ZP + 4 * lane);
            if (t + 2 < T) R.cv3 = *(const u32x2*)(z + 2 * ZP + 4 * lane);
            R.gt = *(const u32x2*)(z + 256 + 4 * lane);
            R.q = *(const u32x4*)(z + 512 + 8 * lane);
            if (lane < 48) R.cq = *(const u32x2*)(z + 1280 + 4 * lane);
            if (lane < 52) R.pz = *(const u32x4*)(z + (lane < 32 ? 1024 + 8 * lane : lane < 48 ? 1472 + 8 * (lane - 32) : 1600 + 8 * (lane - 48)));
        } else if (lane < 52) {
            const size_t cr = ((size_t)b * 4 + l) * 256 + t;
            const float* src = lane < 16 ? INP(p, 2) + cr * 128 + 8 * lane : lane < 32 ? INP(p, 3) + cr * 128 + 8 * (lane - 16) : lane < 48 ? INP(p, 4) + cr * 128 + 8 * (lane - 32) : INP(p, 5) + cr * 32 + 8 * (lane - 48);
            R.pa = *(const f32x4*)src; R.pb = *(const f32x4*)(src + 4);
        }
    }
}
__device__ __forceinline__ void post_process(const Params& p, unsigned char* ws, float* out, int l, int item, int lane, const PostRow& R, const LAS float* tb) {
    const bf16_t* Z = (const bf16_t*)(ws + WS_H);
    float* XCf = (float*)(ws + WS_XCF); bf16_t* XCb = (bf16_t*)(ws + WS_XCB); bf16_t* GA = (bf16_t*)(ws + WS_GA);
    bf16_t* Qg = (bf16_t*)(ws + WS_QG); bf16_t* Kg = (bf16_t*)(ws + WS_KG); bf16_t* Vtg = (bf16_t*)(ws + WS_VTG);
    bf16_t* CQN = (bf16_t*)(ws + WS_CQN); bf16_t* CKV = (bf16_t*)(ws + WS_CKV); bf16_t* Kc = (bf16_t*)(ws + WS_KC);
    const LAS float* convw = tb; const LAS float* convb = tb + 1024; const LAS float* qn = tb + 1280; const LAS float* kn = tb + 1344; const LAS float* mqn = tb + 1408; const LAS float* mkn = tb + 1600;
    const LAS f32x2* r64 = (const LAS f32x2*)(tb + 1728); const LAS f32x2* r32t = (const LAS f32x2*)(tb + 3776);
    {
        POST_DECODE
        const f32x4 cvx[4] = {bf4(R.cv0), bf4(R.cv1), bf4(R.cv2), bf4(R.cv3)}; const f32x4 gt = bf4(R.gt), qa = bf4((u32x2){R.q.x, R.q.y}), qbv = bf4((u32x2){R.q.z, R.q.w}), cqv = bf4(R.cq);
        const f32x4 pa = cache ? R.pa : bf4((u32x2){R.pz.x, R.pz.y}), pb = cache ? R.pb : bf4((u32x2){R.pz.z, R.pz.w});
        if (!cache) {
            { const int c = 4 * lane; f32x4 acc = *(const LAS f32x4*)(convb + c);
#pragma unroll
              for (int j = 0; j < 4; ++j) { const f32x4 w = *(const LAS f32x4*)(convw + j * 256 + c); acc = acc + w * cvx[j]; }
              u32x2 w; w.x = pk2(acc.x, acc.y); w.y = pk2(acc.z, acc.w); *(u32x2*)(XCb + (size_t)row * 256 + c) = w; }
            { f32x4 g = gt; g.x = gelu_tanh(g.x); g.y = gelu_tanh(g.y); g.z = gelu_tanh(g.z); g.w = gelu_tanh(g.w); u32x2 gw; gw.x = pk2(g.x, g.y); gw.y = pk2(g.z, g.w); *(u32x2*)(GA + ((((size_t)(lane >> 1)) * NTOK + row) << 3) + 4 * (lane & 1)) = gw; }
            { float y[8] = {qa.x, qa.y, qa.z, qa.w, qbv.x, qbv.y, qbv.z, qbv.w};
              float ss = 0.f;
#pragma unroll
              for (int i = 0; i < 8; ++i) ss += y[i] * y[i];
              ss += shx(ss, 1, lane); ss += shx(ss, 2, lane); ss += shx(ss, 4, lane);
              const float rstd = rsqrtf(ss * (1.f / 64.f) + 1e-6f);
#pragma unroll
              for (int i = 0; i < 8; ++i) y[i] = y[i] * rstd * qn[(lane & 7) * 8 + i];
              const int pos = ((lane & 3) < 2) ? grow : gcol; const LAS f32x2* cs = r64 + pos * 16 + (lane & 1) * 8;
              const float sg = (lane & 4) ? 1.f : -1.f;
#pragma unroll
              for (int i = 0; i < 8; ++i) { const float pa_ = shx(y[i], 4, lane); if (samp) { const f32x2 c = cs[i]; y[i] = y[i] * c.x + sg * pa_ * c.y; } }
              u32x4 w; w.x = pk2(y[0] * C2G, y[1] * C2G); w.y = pk2(y[2] * C2G, y[3] * C2G); w.z = pk2(y[4] * C2G, y[5] * C2G); w.w = pk2(y[6] * C2G, y[7] * C2G);
              *(u32x4*)(Qg + (size_t)row * 512 + 8 * lane) = w; }
            { f32x4 v = cqv;
              const float ss = wave_sum(v.x * v.x + v.y * v.y + v.z * v.z + v.w * v.w, lane);
              const float rstd = rsqrtf(ss * (1.f / 192.f) + 1e-6f);
              u32x2 w = (u32x2){0u, 0u};
              if (lane < 48) { const f32x4 g = *(const LAS f32x4*)(mqn + 4 * lane); v = v * rstd * g; w.x = pk2(v.x, v.y); w.y = pk2(v.z, v.w); }
              *(u32x2*)(CQN + (size_t)row * 256 + 4 * lane) = w; }
        }
        {
            float y[8] = {pa.x, pa.y, pa.z, pa.w, pb.x, pb.y, pb.z, pb.w};
            float ss = 0.f;
#pragma unroll
            for (int i = 0; i < 8; ++i) ss += y[i] * y[i];
            ss += shx(ss, 1, lane); ss += shx(ss, 2, lane); ss += shx(ss, 4, lane);
            const float ss16 = ss + shx(ss, 8, lane);
            if (!cache) {
                if (lane < 16) { const float rstd = rsqrtf(ss * (1.f / 64.f) + 1e-6f);
#pragma unroll
                    for (int i = 0; i < 8; ++i) y[i] = y[i] * rstd * kn[(lane & 7) * 8 + i]; }
                else if (lane >= 32 && lane < 48) { const float rstd = rsqrtf(ss16 * (1.f / 128.f) + 1e-6f);
#pragma unroll
                    for (int i = 0; i < 8; ++i) y[i] = y[i] * rstd * mkn[(lane - 32) * 8 + i]; }
            }
            if (!cache && !samp && lane < 52) {
                const size_t cr = ((size_t)b * 4 + l) * 256 + t;
                float* op = lane < 16 ? out + O_K + cr * 128 + 8 * lane : lane < 32 ? out + O_V + cr * 128 + 8 * (lane - 16) : lane < 48 ? out + O_CKV + cr * 128 + 8 * (lane - 32) : out + O_KR + cr * 32 + 8 * (lane - 48);
                *(f32x4*)op = (f32x4){y[0], y[1], y[2], y[3]}; *(f32x4*)(op + 4) = (f32x4){y[4], y[5], y[6], y[7]};
            }
            {
                const bool dorope = samp && !cache;
                const int posk = ((lane & 3) < 2) ? grow : gcol; const LAS f32x2* csk = r64 + posk * 16 + (lane & 1) * 8;
                const int posr = (lane & 1) ? gcol : grow; const LAS f32x2* csr = r32t + posr * 8;
                const float sgk = (lane & 4) ? 1.f : -1.f, sgr = (lane & 2) ? 1.f : -1.f;
#pragma unroll
                for (int i = 0; i < 8; ++i) {
                    const float p4 = shx(y[i], 4, lane), p2 = shx(y[i], 2, lane);
                    if (dorope) {
                        if (lane < 16) { const f32x2 c = csk[i]; y[i] = y[i] * c.x + sgk * p4 * c.y; }
                        else if (lane >= 48 && lane < 52) { const f32x2 c = csr[i]; y[i] = y[i] * c.x + sgr * p2 * c.y; }
                    }
                }
            }
            u32x4 w; w.x = pk2(y[0], y[1]); w.y = pk2(y[2], y[3]); w.z = pk2(y[4], y[5]); w.w = pk2(y[6], y[7]);
            if (lane < 16) {
                bf16_t* kp = samp ? Kg + KG_S + ((size_t)b * SKV + (cache ? t : 256 + t)) * 128 : Kg + ((size_t)b * 256 + t) * 128;
                *(u32x4*)(kp + 8 * lane) = w;
            } else if (lane < 32) {
                bf16_t* vp = samp ? Vtg + KG_S + ((size_t)b * SKV + (cache ? t : 256 + t)) * 128 : Vtg + ((size_t)b * 256 + t) * 128;
                *(u32x4*)(vp + 8 * (lane - 16)) = w;
            } else if (lane < 48) {
                *(u32x4*)(CKV + rowc * 256 + 8 * (lane - 32)) = w;
            } else if (lane < 52) {
                bf16_t* kp = Kc + rowc * 384 + 64 + 8 * (lane - 48);
                *(u32x4*)kp = w; *(u32x4*)(kp + 96) = w; *(u32x4*)(kp + 192) = w; *(u32x4*)(kp + 288) = w;
            }
            if (lane >= 48) { const unsigned zz = __builtin_bit_cast(unsigned, ozero()); *(u32x4*)(CKV + rowc * 256 + 128 + 8 * (lane - 48)) = (u32x4){zz, zz, zz, zz}; }
        }
    }
}
__device__ __forceinline__ void post_phase(int wv, const Params& p, unsigned char* ws, float* out, int l, LAS unsigned char* lds) {
    const int tid = otid(wv), lane = tid & 63, wave = tid >> 6;
    LAS float* tb = (LAS float*)lds;
    {
        const float* cw = INP(p, 18) + (size_t)l * 1024; const float* cb = INP(p, 19) + (size_t)l * 256;
        const float* qn_ = INP(p, 25) + l * 64; const float* kn_ = INP(p, 26) + l * 64; const float* mqn_ = INP(p, 27) + l * 192; const float* mkn_ = INP(p, 29) + l * 128;
        const float* r64_ = (const float*)(ws + WS_R64); const float* r32_ = (const float*)(ws + WS_R32);
        for (int i = tid; i < 4800; i += 512) {
            float v;
            if (i < 1024) v = cw[i]; else if (i < 1280) v = cb[i - 1024]; else if (i < 1344) v = qn_[i - 1280]; else if (i < 1408) v = kn_[i - 1344];
            else if (i < 1600) v = mqn_[i - 1408]; else if (i < 1728) v = mkn_[i - 1600]; else if (i < 3776) v = r64_[i - 1728]; else v = r32_[i - 3776];
            tb[i] = v;
        }
        __syncthreads();
    }
    constexpr int NITEM = NTOK + 1024;
    const int G = ogd(), per = (NITEM + G - 1) / G, lo = obx() * per, hi_ = (lo + per < NITEM) ? lo + per : NITEM;
    int item = lo + wave;
    PostRow cur = {}, nxt = {};
    if (item < hi_) post_load(p, ws, l, item, lane, cur);
    while (item < hi_) {
        const int nitem = item + 8;
        if (nitem < hi_) post_load(p, ws, l, nitem, lane, nxt);
        post_process(p, ws, out, l, item, lane, cur, tb);
        cur = nxt; item = nitem;
    }
}

__device__ __forceinline__ void mixer_phase(int wv, const Params& p, unsigned char* ws, float* out, int l, LAS unsigned char* lds, int mask) {
    const bf16_t* Qg = (const bf16_t*)(ws + WS_QG); const bf16_t* Kg = (const bf16_t*)(ws + WS_KG); const bf16_t* Vtg = (const bf16_t*)(ws + WS_VTG);
    const bf16_t* Qc = (const bf16_t*)(ws + WS_QC); const bf16_t* Kc = (const bf16_t*)(ws + WS_KC); const bf16_t* Vtc = (const bf16_t*)(ws + WS_VTC);
    bf16_t* MIX = (bf16_t*)(ws + WS_U);
    const float* A = (const float*)(ws + WS_A); bf16_t* HF = (bf16_t*)(ws + WS_HF); bf16_t* HB = (bf16_t*)(ws + WS_HB); const bf16_t* U = (const bf16_t*)(ws + WS_UU); const bf16_t* Z = (const bf16_t*)(ws + WS_GA);
    const int G = ogd(), bx = obx();
    if (mask & 1) for (int it = 0; it < 2; ++it) {
        if (bx < 128 && it) break;
        const int u = (bx < 128) ? bx : bx + it * 128;
        if (u < 128) { const int b = u >> 5, cg8 = u & 31; const float* st = INP(p, 6) + ((size_t)b * 4 + l) * 512;
            scan_unit<8>(wv, lds, A, HF, HB, U, Z, MIX, (size_t)NP + (size_t)b * 4096, 4096, st, st + 256, nullptr, nullptr, cg8 * 8); }
        else { const int v = u - 128, b = v >> 3, cg8 = v & 7; float* so = out + O_LRU + ((size_t)b * 4 + l) * 512;
            scan_unit<32>(wv, lds, A, HF, HB, U, Z, MIX, (size_t)b * 256, 256, nullptr, nullptr, so, so + 256, cg8 * 32); }
    }
    if (mask & 2) for (int i = 0; i < 2; ++i) {
        const int xcd = bx & 7, idx = (bx >> 3) * 2 + i;
        const int qb = idx & 15, h = (xcd & 1) * 4 + (idx >> 4), b = xcd >> 1, kvh = h >> 2; const size_t row0 = (size_t)NP + (size_t)b * 4096 + qb * 256;
        attn_unit<64>(wv, lds, Qg + row0 * 512 + h * 64, 512, Kg + KG_S + (size_t)b * SKV * 128 + kvh * 64, 128, Vtg + KG_S + (size_t)b * SKV * 128 + kvh * 64, 128, SKV, MIX + row0 * 1024 + 256 + h * 64, 1024);
    }
    if (mask & 4) {
        const int xcd = bx & 7, slot = bx >> 3;
        const int qb = slot & 15, h = (xcd & 1) * 2 + (slot >> 4), b = xcd >> 1; const size_t row0 = (size_t)NP + (size_t)b * 4096 + qb * 256;
        attn_unit<96>(wv, lds, Qc + row0 * 384 + h * 96, 384, Kc + ((size_t)NP + (size_t)b * SKV) * 384 + h * 96, 384, Vtc + ((size_t)NP + (size_t)b * SKV) * 256 + h * 64, 256, SKV, MIX + row0 * 1024 + 768 + h * 64, 1024);
    }
    if (mask & 8) for (int u = bx - 128; u < 256; u += 128) {
        if (u < 0) break;
        const int h = u & 7, b = u >> 3, kvh = h >> 2; const size_t row0 = (size_t)b * 256;
        attn_unit<64>(wv, lds, Qg + row0 * 512 + h * 64, 512, Kg + (size_t)b * 256 * 128 + kvh * 64, 128, Vtg + (size_t)b * 256 * 128 + kvh * 64, 128, 256, MIX + row0 * 1024 + 256 + h * 64, 1024);
    }
    if (mask & 16) for (int u = (bx + 128) & 255; u < 128; u += G) {
        const int h = u & 3, b = u >> 2; const size_t row0 = (size_t)b * 256;
        attn_unit<96>(wv, lds, Qc + row0 * 384 + h * 96, 384, Kc + row0 * 384 + h * 96, 384, Vtc + row0 * 256 + h * 64, 256, 256, MIX + row0 * 1024 + 768 + h * 64, 1024);
    }
}

#define XB_TMO      128
#define XB_XCNT(j)  (256  + 64 * (j))
#define XB_XSUB(j)  (1280 + 64 * (j))
#define XB_XGEN(j)  (2304 + 64 * (j))
#define XB_TOP      3328
#define XB_TOPGEN   3392
#define XB_SPIN_CAP (1u << 18)
__device__ __forceinline__ unsigned xb_ld(unsigned* p)              { return __hip_atomic_load(p, __ATOMIC_RELAXED, __HIP_MEMORY_SCOPE_AGENT); }
__device__ __forceinline__ unsigned xb_add(unsigned* p, unsigned v) { return __hip_atomic_fetch_add(p, v, __ATOMIC_RELAXED, __HIP_MEMORY_SCOPE_AGENT); }
__device__ __forceinline__ unsigned xb_xcc_id() { return (unsigned)__builtin_amdgcn_s_getreg((3 << 11) | 20) & 0xFu; }
#define XB_SPIN(cond, bar) do { unsigned _sp = 0; while (cond) { __builtin_amdgcn_s_sleep(1); \
    if ((++_sp & 255u) == 0u) { if (xb_ld(&(bar)[XB_TMO])) break; if (_sp > XB_SPIN_CAP) { atomicAdd(&(bar)[XB_TMO], 1u); break; } } } } while (0)
__device__ __forceinline__ void xcd_barrier_complete(unsigned* bar, unsigned x, unsigned& nloc, unsigned& nx) {
    const unsigned G = gridDim.x;
    unsigned sum, cnt, mine, sp = 0u;
    for (;;) {
        sum = 0u; cnt = 0u; mine = 0u;
#pragma unroll
        for (unsigned j = 0; j < 16; ++j) { const unsigned c = xb_ld(&bar[XB_XCNT(j)]); sum += c; cnt += (c > 0u) ? 1u : 0u; mine = (j == x) ? c : mine; }
        if (sum == G) break;
        __builtin_amdgcn_s_sleep(1);
        if ((++sp & 255u) == 0u) { if (xb_ld(&bar[XB_TMO])) break; if (sp > XB_SPIN_CAP) { atomicAdd(&bar[XB_TMO], 1u); break; } }
    }
    nloc = mine > 0u ? mine : 1u; nx = cnt > 0u ? cnt : 1u;
}
__device__ __forceinline__ void xcd_barrier(int wv, unsigned* bar, volatile LAS unsigned* st) {
    asm volatile("s_waitcnt vmcnt(0)" ::: "memory");
    __syncthreads();
    if (otid(wv) == 0) {
        const unsigned x = xb_xcc_id();
        __builtin_amdgcn_s_waitcnt(0);
        unsigned nloc = st[0], nx = st[1];
        if (nloc == 0u) { xcd_barrier_complete(bar, x, nloc, nx); st[0] = nloc; st[1] = nx; }
        const unsigned old = xb_add(&bar[XB_XSUB(x)], 1u);
        const unsigned gen = old / nloc;
        if (old + 1u == (gen + 1u) * nloc) {
            __builtin_amdgcn_fence(__ATOMIC_RELEASE, "agent");
            asm volatile("s_waitcnt vmcnt(0)" ::: "memory");
            const unsigned og = xb_add(&bar[XB_TOP], 1u);
            const unsigned tg = og / nx;
            if (og + 1u == (tg + 1u) * nx) xb_add(&bar[XB_TOPGEN], 1u);
            else XB_SPIN(xb_ld(&bar[XB_TOPGEN]) == tg, bar);
            __builtin_amdgcn_fence(__ATOMIC_ACQUIRE, "agent");
            xb_add(&bar[XB_XGEN(x)], 1u);
            asm volatile("s_waitcnt vmcnt(0)" ::: "memory");
        } else {
            XB_SPIN(xb_ld(&bar[XB_XGEN(x)]) == gen, bar);
            __builtin_amdgcn_fence(__ATOMIC_ACQUIRE, "agent");
            asm volatile("s_waitcnt vmcnt(0)" ::: "memory");
        }
    }
    __syncthreads();
}

constexpr int N_PHASES = 2 + 12 * NLAYER;
__global__ void __launch_bounds__(512, 2) fwd_megakernel(Params p) {
    extern __shared__ __attribute__((aligned(16))) unsigned char lds_raw[];
    LAS unsigned char* lds = (LAS unsigned char*)lds_raw;
    cg::grid_group grid = cg::this_grid();
    const int wv = __builtin_amdgcn_readfirstlane((int)(threadIdx.x >> 6));
    volatile LAS unsigned* bst = (volatile LAS unsigned*)(lds + 131072 + 512);
    if (threadIdx.x == 0) { bst[0] = 0u; bst[1] = 0u; (void)xb_add((unsigned*)(p.ws + WS_BAR) + XB_XCNT(xb_xcc_id()), 1u); }
    __syncthreads();
    for (int ph = p.ph_lo; ph < p.ph_hi; ++ph) {
        __attribute__((address_space(1))) unsigned char* wsg = (__attribute__((address_space(1))) unsigned char*)p.ws;
        __attribute__((address_space(1))) float* outg = (__attribute__((address_space(1))) float*)p.out;
        asm volatile("" : "+s"(wsg), "+s"(outg));
        unsigned char* ws = (unsigned char*)wsg; float* out = (float*)outg;
        const float* mod = (const float*)(ws + WS_MOD);
        float* X = out;
        if (ph == 0) { phase_prologue0(wv, p, ws, lds); if (DUP_K == 101) { __syncthreads(); phase_prologue0(wv, p, ws, lds); } }
        else if (ph == 1) { ln_phase(wv, p, ws, out, 0, 0, 0, 0, true); if (DUP_K == 100) { ln_phase(wv, p, ws, out, 0, 0, 0, 0, true); ln_phase(wv, p, ws, out, 0, 0, 0, 0, true); ln_phase(wv, p, ws, out, 0, 0, 0, 0, true); ln_phase(wv, p, ws, out, 0, 0, 0, 0, true); } }
        else {
            const int l = (ph - 2) / 12, k = (ph - 2) % 12;
            const float* modl = mod + (size_t)l * 5 * 9216;
            if (k == 0 || k == 9) {
                const int j = k ? 1 : 0;
                pg8::Gemm g{(const bf16_t*)(ws + WS_U), (const bf16_t*)(ws + WS_WGU + (size_t)j * 5632 * 1024), NTOK, 5632, DM / 2};
                pg8::StaticOrder S; S.init(NTOK, 5632, ogd(), obx());
                EpiSwiGLU E{(unsigned char*)(ws + WS_H)};
                pg8::gemm_phase<EpiSwiGLU, true>(wv, lds, g, S, E);
                if (DUP_K == 0 && k == 0) pg8::gemm_phase<EpiSwiGLU, true>(wv, lds, g, S, E);
            } else if (k == 1 || k == 10) {
                const int j = (k == 10) ? 1 : 0;
                pg8::Gemm g{(const bf16_t*)(ws + WS_H), (const bf16_t*)(ws + WS_WD + (size_t)j * 1024 * 2816), NTOK, DM, DFF / 2};
                pg8::StaticOrder S; S.init(NTOK, DM, ogd(), obx());
                const int lnix = (j == 0 && l == 0) ? -1 : (j ? l * 3 + 1 : (l - 1) * 3 + 2);
                EpiResid E{X, modl, (const float*)(ws + WS_ST), j ? 8 : 2, 0.5f / WD_SCALE, lnix, 0};
                pg8::gemm_phase<EpiResid, true>(wv, lds, g, S, E);
                if (DUP_K == 103) { EpiDiscard E2{(float*)(ws + WS_BAR + 8192)}; pg8::gemm_phase<EpiDiscard, true>(wv, lds, g, S, E2); }
            } else if (k == 2) ln_phase(wv, p, ws, out, l, 0, l, 1, false);
            else if (k == 3) {
                pg8::Gemm g{(const bf16_t*)(ws + WS_U), (const bf16_t*)(ws + WS_WIN), NTOK, 1792, DM};
                pg8::StaticOrder S; S.init(NTOK, 1792, ogd(), obx());
                EpiZ E{(bf16_t*)(ws + WS_H)};
                pg8::gemm_phase(wv, lds, g, S, E);
                if (DUP_K == 3) pg8::gemm_phase(wv, lds, g, S, E);
            } else if (k == 4) { post_phase(wv, p, ws, out, l, lds); if (DUP_K == 4) post_phase(wv, p, ws, out, l, lds); }
            else if (k == 5) {
                { pg8::Gemm g{(const bf16_t*)(ws + WS_XCB), (const bf16_t*)(ws + WS_WLRU), NTOK, 1024, 256};
                  pg8::StaticOrder S; S.init(NTOK, 1024, ogd(), obx());
                  EpiLru E{(const bf16_t*)(ws + WS_XCB), (float*)(ws + WS_A), (bf16_t*)(ws + WS_UU), INP(p, 21) + l * 512, INP(p, 23) + l * 512, (const float*)(ws + WS_SPT) + l * 512};
                  pg8::gemm_phase(wv, lds, g, S, E); }
                { pg8::Gemm g{(const bf16_t*)(ws + WS_CQN), (const bf16_t*)(ws + WS_WUQ), NTOK, 512, 256};
                  pg8::StaticOrder S; S.init(NTOK, 512, ogd(), (obx() + 128) & 255);
                  EpiQc E{(bf16_t*)(ws + WS_QC), (const f32x2*)(ws + WS_R32)};
                  pg8::gemm_phase(wv, lds, g, S, E); }
                { pg8::Gemm g{(const bf16_t*)(ws + WS_CKV), (const bf16_t*)(ws + WS_WUKV), NCKV, 512, 256};
                  const int cb_ = obx(); pg8::StaticOrder S; S.init(NCKV, 512, ogd(), cb_ >= 128 ? cb_ - 128 : (cb_ >= 64 ? cb_ + 64 : cb_ + 192));
                  EpiKv E{(bf16_t*)(ws + WS_KC), (bf16_t*)(ws + WS_VTC)};
                  pg8::gemm_phase(wv, lds, g, S, E); }
                if (DUP_K == 5) {
                { pg8::Gemm g{(const bf16_t*)(ws + WS_XCB), (const bf16_t*)(ws + WS_WLRU), NTOK, 1024, 256};
                  pg8::StaticOrder S; S.init(NTOK, 1024, ogd(), obx());
                  EpiLru E{(const bf16_t*)(ws + WS_XCB), (float*)(ws + WS_A), (bf16_t*)(ws + WS_UU), INP(p, 21) + l * 512, INP(p, 23) + l * 512, (const float*)(ws + WS_SPT) + l * 512};
                  pg8::gemm_phase(wv, lds, g, S, E); }
                { pg8::Gemm g{(const bf16_t*)(ws + WS_CQN), (const bf16_t*)(ws + WS_WUQ), NTOK, 512, 256};
                  pg8::StaticOrder S; S.init(NTOK, 512, ogd(), (obx() + 128) & 255);
                  EpiQc E{(bf16_t*)(ws + WS_QC), (const f32x2*)(ws + WS_R32)};
                  pg8::gemm_phase(wv, lds, g, S, E); }
                { pg8::Gemm g{(const bf16_t*)(ws + WS_CKV), (const bf16_t*)(ws + WS_WUKV), NCKV, 512, 256};
                  const int cb_ = obx(); pg8::StaticOrder S; S.init(NCKV, 512, ogd(), cb_ >= 128 ? cb_ - 128 : (cb_ >= 64 ? cb_ + 64 : cb_ + 192));
                  EpiKv E{(bf16_t*)(ws + WS_KC), (bf16_t*)(ws + WS_VTC)};
                  pg8::gemm_phase(wv, lds, g, S, E); }
                }
            } else if (k == 6) { mixer_phase(wv, p, ws, out, l, lds, 31); if (DUP_K == 6) mixer_phase(wv, p, ws, out, l, lds, DUP_SUB); }
            else if (k == 7) {
                pg8::Gemm g{(const bf16_t*)(ws + WS_U), (const bf16_t*)(ws + WS_WOUT), NTOK, DM, DM};
                pg8::StaticOrder S; S.init(NTOK, DM, ogd(), obx());
                EpiResid E{X, modl, (const float*)(ws + WS_ST), 5, 1.0f, l * 3, 0};
                pg8::gemm_phase(wv, lds, g, S, E);
            } else if (k == 8) ln_phase(wv, p, ws, out, l, 1, l, 2, false);
            else {
                ln_phase(wv, p, ws, out, l, 2, l + 1, (l + 1 < NLAYER) ? 0 : -1, false);
                if (l + 1 < NLAYER) weight_prep(wv, p, ws, l + 1, lds);
                if (DUP_K == 102 && l + 1 < NLAYER) { __syncthreads(); weight_prep(wv, p, ws, l + 1, lds); }
            }
        }
        if (ph + 1 < p.ph_hi) { if (p.ph_lo < 0) grid.sync(); else { xcd_barrier(wv, (unsigned*)(ws + WS_BAR), bst); if (DUP_K == 200) { xcd_barrier(wv, (unsigned*)(ws + WS_BAR), bst); xcd_barrier(wv, (unsigned*)(ws + WS_BAR), bst); } } }
    }
}

extern "C" void kernel_launch(void* const* d_in, const int* in_sizes, int n_in, void* d_out, int out_size, void* d_ws, size_t ws_size, hipStream_t stream) {
    static int grid = 0;
    if (grid == 0) {
        if (n_in != 32 || out_size != 38862848 || ws_size < WS_END) { fprintf(stderr, "kernel_launch: unexpected problem (n_in %d out %d ws %zu need %zu)\n", n_in, out_size, ws_size, (size_t)WS_END); grid = -1; return; }
        int dev = 0, cus = 0, per_cu = 0;
        hipGetDevice(&dev); hipDeviceGetAttribute(&cus, hipDeviceAttributeMultiprocessorCount, dev);
        hipFuncSetAttribute((const void*)fwd_megakernel, hipFuncAttributeMaxDynamicSharedMemorySize, LDS_BYTES);
        hipOccupancyMaxActiveBlocksPerMultiprocessor(&per_cu, (const void*)fwd_megakernel, 512, LDS_BYTES);
        (void)hipGetLastError();
        if (per_cu < 1) per_cu = 1;
        grid = cus;
        if (cus != 256) { fprintf(stderr, "kernel_launch: built for a 256-CU device (unit dealing assumes 256 workgroups), found %d CUs; nothing launched\n", cus); grid = -1; return; }
    }
    if (grid < 0) return;
    Params p{};
    for (int i = 0; i < 32; ++i) p.in[i] = (const float*)d_in[i];
    p.out = (float*)d_out; p.ws = (unsigned char*)d_ws;
    if (hipMemsetAsync((char*)d_ws + WS_BAR, 0, 16384, stream) != hipSuccess) { fprintf(stderr, "memset failed\n"); return; }
#if MK_PER_PHASE_LAUNCH
    for (int ph = 0; ph < N_PHASES; ++ph) {
        p.ph_lo = ph; p.ph_hi = ph + 1;
        void* args[] = {&p};
        hipError_t e = hipLaunchCooperativeKernel((void*)fwd_megakernel, dim3(grid), dim3(512), args, LDS_BYTES, stream);
        if (e != hipSuccess) { fprintf(stderr, "launch failed: %s\n", hipGetErrorString(e)); break; }
    }
#else
    p.ph_lo = 0; p.ph_hi = N_PHASES;
    void* args[] = {&p};
    hipError_t e = hipLaunchCooperativeKernel((void*)fwd_megakernel, dim3(grid), dim3(512), args, LDS_BYTES, stream);
    if (e != hipSuccess) fprintf(stderr, "cooperative launch failed: %s (grid %d)\n", hipGetErrorString(e), grid);
#endif
}
```
